# Optimizing an MI355X kernel written in HIP

```python
import jax, jax.numpy as jnp
from jax import lax
import numpy as np

D_MODEL = 1024
BATCH = 4
SEQ = 4096
DEPTH = 1
DEC_BATCH = 128
DEC_SEQ = 1
PAST_LEN = 8192
PAGE_SIZE = 128

MIX_WIDTH = D_MODEL
MLSTM_HEADS = 4
MLSTM_HEAD_DIM = MIX_WIDTH // 2 // MLSTM_HEADS
MLSTM_WIDTH = MLSTM_HEADS * MLSTM_HEAD_DIM
MLSTM_CHUNK = 128
SWA_HEADS = 8
SWA_HEAD_DIM = (MIX_WIDTH - MLSTM_WIDTH) // SWA_HEADS
SWA_WIDTH = SWA_HEADS * SWA_HEAD_DIM
SWA_KV_HEADS = 2
SWA_GROUP = SWA_HEADS // SWA_KV_HEADS
SWA_KV_WIDTH = SWA_KV_HEADS * SWA_HEAD_DIM
WINDOW = 128
SWA_BLOCK = WINDOW
D_FF = 2816
FFN_RES_WEIGHT = 0.5
RMS_EPS = 1e-6
GATE_PAD = -1e30
PROJ_WIDTH = 4 * MLSTM_WIDTH + 2 * MLSTM_HEADS + SWA_WIDTH + 2 * SWA_KV_WIDTH

kernel_name = 'hymba_mlstm_swa_macaron_step'


def rms_norm(x, gain):
    xf = x.astype(jnp.float32)
    y = xf * lax.rsqrt(jnp.mean(xf * xf, axis=-1, keepdims=True) + RMS_EPS)
    return (y * gain.astype(jnp.float32)).astype(x.dtype)


def swiglu(x, w_gate, w_up, w_down):
    return (jax.nn.silu(x @ w_gate) * (x @ w_up)) @ w_down


def proj_split_points():
    sizes = [MLSTM_WIDTH] * 4 + [MLSTM_HEADS] * 2 + [SWA_WIDTH, SWA_KV_WIDTH, SWA_KV_WIDTH]
    return [int(s) for s in np.cumsum(sizes)[:-1]]


def mlstm_chunkwise(q, k, v, i_pre, log_f, c0, n0, m0):
    b_, t_, h_, dh = q.shape
    L = min(MLSTM_CHUNK, t_)
    n_chunks = -(-t_ // L)
    pad = n_chunks * L - t_
    if pad:
        pw = ((0, 0), (0, pad), (0, 0), (0, 0))
        q, k, v = jnp.pad(q, pw), jnp.pad(k, pw), jnp.pad(v, pw)
        i_pre = jnp.pad(i_pre, pw[:3], constant_values=GATE_PAD)
        log_f = jnp.pad(log_f, pw[:3])

    def to_chunks(a):
        return jnp.moveaxis(a.reshape((b_, n_chunks, L) + a.shape[2:]), 1, 0)

    causal = jnp.tril(jnp.ones((L, L), dtype=bool))[None, :, :, None]

    def step(carry, xs):
        c, n, m = carry
        qj, kj, vj, ij, fj = xs
        bcum = jnp.cumsum(fj, axis=1)
        log_inter = bcum + m[:, None, :]
        log_intra = bcum[:, :, None, :] - bcum[:, None, :, :] + ij[:, None, :, :]
        log_intra = jnp.where(causal, log_intra, -jnp.inf)
        m_t = jnp.maximum(log_inter, jnp.max(log_intra, axis=2))
        w_inter = jnp.exp(log_inter - m_t)
        scores = jnp.einsum('bthd,bshd->btsh', qj, kj) * jnp.exp(log_intra - m_t[:, :, None, :])
        num = w_inter[..., None] * jnp.einsum('bhvk,bthk->bthv', c, qj) + jnp.einsum('btsh,bshv->bthv', scores, vj)
        den = w_inter * jnp.einsum('bhk,bthk->bth', n, qj) + jnp.sum(scores, axis=2)
        h = num / jnp.maximum(jnp.abs(den), jnp.exp(-m_t))[..., None]
        b_last = bcum[:, -1, :]
        log_end = b_last[:, None, :] - bcum + ij
        m_new = jnp.maximum(b_last + m, jnp.max(log_end, axis=1))
        decay = jnp.exp(b_last + m - m_new)
        w_end = jnp.exp(log_end - m_new[:, None, :])
        c_new = decay[..., None, None] * c + jnp.einsum('bsh,bshv,bshk->bhvk', w_end, vj, kj)
        n_new = decay[..., None] * n + jnp.einsum('bsh,bshk->bhk', w_end, kj)
        return (c_new, n_new, m_new), h

    xs = (to_chunks(q), to_chunks(k), to_chunks(v), to_chunks(i_pre), to_chunks(log_f))
    (c1, n1, m1), hs = lax.scan(step, (c0, n0, m0), xs)
    hs = jnp.moveaxis(hs, 0, 1).reshape(b_, n_chunks * L, h_, dh)[:, :t_]
    return hs, (c1, n1, m1)


def mlstm_mixer(q_m, k_m, v_m, o_m, i_m, f_m, b_i, b_f, out_gain, c0, n0, m0):
    b_, t_, _ = q_m.shape
    shp = (b_, t_, MLSTM_HEADS, MLSTM_HEAD_DIM)
    q = q_m.reshape(shp).astype(jnp.float32)
    k = k_m.reshape(shp).astype(jnp.float32) * (MLSTM_HEAD_DIM ** -0.5)
    v = v_m.reshape(shp).astype(jnp.float32)
    i_pre = i_m.astype(jnp.float32) + b_i.astype(jnp.float32)
    log_f = jax.nn.log_sigmoid(f_m.astype(jnp.float32) + b_f.astype(jnp.float32))
    h, state = mlstm_chunkwise(q, k, v, i_pre, log_f, c0.astype(jnp.float32),
                               n0.astype(jnp.float32), m0.astype(jnp.float32))
    h = h * lax.rsqrt(jnp.mean(h * h, axis=-1, keepdims=True) + RMS_EPS)
    h = h * out_gain.astype(jnp.float32).reshape(MLSTM_HEADS, MLSTM_HEAD_DIM)
    h = h.reshape(b_, t_, MLSTM_WIDTH) * jax.nn.sigmoid(o_m.astype(jnp.float32))
    return h.astype(q_m.dtype), state


def sink_softmax(s, sink):
    mx = jnp.maximum(jnp.max(s, axis=-1, keepdims=True), sink)
    p = jnp.exp(s - mx)
    return p / (jnp.sum(p, axis=-1, keepdims=True) + jnp.exp(sink - mx))


def swa_banded(q, k, v, sinks):
    b_, t_, _, dh = q.shape
    nb = t_ // SWA_BLOCK
    qb = q.reshape(b_, nb, SWA_BLOCK, SWA_KV_HEADS, SWA_GROUP, dh)
    kb = k.reshape(b_, nb, SWA_BLOCK, SWA_KV_HEADS, dh)
    vb = v.reshape(b_, nb, SWA_BLOCK, SWA_KV_HEADS, dh)
    shift = ((0, 0), (1, 0), (0, 0), (0, 0), (0, 0))
    k_band = jnp.concatenate([jnp.pad(kb, shift)[:, :-1], kb], axis=2)
    v_band = jnp.concatenate([jnp.pad(vb, shift)[:, :-1], vb], axis=2)
    s = jnp.einsum('bnqkgd,bnskd->bnkgqs', qb, k_band).astype(jnp.float32) * (dh ** -0.5)
    q_pos = jnp.arange(SWA_BLOCK)[:, None] + SWA_BLOCK
    k_pos = jnp.arange(2 * SWA_BLOCK)[None, :]
    blk_start = (jnp.arange(nb) - 1) * SWA_BLOCK
    mask = ((k_pos <= q_pos) & (k_pos >= q_pos - WINDOW))[None] & ((blk_start[:, None, None] + k_pos[None]) >= 0)
    s = jnp.where(mask[None, :, None, None], s, -jnp.inf)
    sink = sinks.astype(jnp.float32).reshape(SWA_KV_HEADS, SWA_GROUP)[None, None, :, :, None, None]
    p = sink_softmax(s, sink)
    o = jnp.einsum('bnkgqs,bnskd->bnqkgd', p.astype(v.dtype), v_band)
    return o.reshape(b_, t_, SWA_WIDTH)


def swa_with_buffer(q, k, v, buf_k, buf_v, sinks):
    b_, t_, _, dh = q.shape
    w = buf_k.shape[1]
    k_all = jnp.concatenate([buf_k.astype(k.dtype), k], axis=1)
    v_all = jnp.concatenate([buf_v.astype(v.dtype), v], axis=1)
    qg = q.reshape(b_, t_, SWA_KV_HEADS, SWA_GROUP, dh)
    s = jnp.einsum('bqkgd,bskd->bkgqs', qg, k_all).astype(jnp.float32) * (dh ** -0.5)
    q_rel = jnp.arange(t_)[:, None]
    k_rel = jnp.arange(w + t_)[None, :] - w
    mask = (k_rel <= q_rel) & (k_rel >= q_rel - WINDOW)
    s = jnp.where(mask, s, -jnp.inf)
    sink = sinks.astype(jnp.float32).reshape(SWA_KV_HEADS, SWA_GROUP)[None, :, :, None, None]
    p = sink_softmax(s, sink)
    o = jnp.einsum('bkgqs,bskd->bqkgd', p.astype(v_all.dtype), v_all)
    return o.reshape(b_, t_, SWA_WIDTH), k_all[:, -w:], v_all[:, -w:]


def trunk_layer(x, p, c0, n0, m0, buf_k, buf_v):
    x = x + FFN_RES_WEIGHT * swiglu(rms_norm(x, p['ffn1_norm']), p['ffn1_w_gate'], p['ffn1_w_up'], p['ffn1_w_down'])
    h = rms_norm(x, p['mix_norm'])
    proj = h @ p['w_in']
    q_m, k_m, v_m, o_m, i_m, f_m, q_a, k_a, v_a = jnp.split(proj, proj_split_points(), axis=-1)
    b_, t_, _ = x.shape
    y_m, (c1, n1, m1) = mlstm_mixer(q_m, k_m, v_m, o_m, i_m, f_m, p['mlstm_b_i'], p['mlstm_b_f'],
                                    p['mlstm_out_norm'], c0, n0, m0)
    q_a = rms_norm(q_a.reshape(b_, t_, SWA_HEADS, SWA_HEAD_DIM), p['swa_q_norm'])
    k_a = rms_norm(k_a.reshape(b_, t_, SWA_KV_HEADS, SWA_HEAD_DIM), p['swa_k_norm'])
    v_a = v_a.reshape(b_, t_, SWA_KV_HEADS, SWA_HEAD_DIM)
    if buf_k is None:
        y_a = swa_banded(q_a, k_a, v_a, p['swa_sinks'])
        w = min(WINDOW, t_)
        new_k, new_v = k_a[:, t_ - w:], v_a[:, t_ - w:]
    else:
        y_a, new_k, new_v = swa_with_buffer(q_a, k_a, v_a, buf_k, buf_v, p['swa_sinks'])
    x = x + jnp.concatenate([y_m, y_a], axis=-1) @ p['w_out']
    x = x + FFN_RES_WEIGHT * swiglu(rms_norm(x, p['ffn2_norm']), p['ffn2_w_gate'], p['ffn2_w_up'], p['ffn2_w_down'])
    return x, (new_k, new_v, c1, n1, m1)


def setup_inputs(seed: int = 0) -> dict:
    key = jax.random.key(seed)
    ks = jax.random.split(key, 32)
    f32 = jnp.float32

    def nrm(k, shape, scale):
        return jax.random.normal(k, shape, f32) * scale

    def gain(k, shape):
        return 1.0 + 0.05 * jax.random.normal(k, shape, f32)

    L, d, hd = DEPTH, D_MODEL, MLSTM_HEAD_DIM
    w_buf = min(WINDOW, PAST_LEN)
    return {
        'x_prompt': nrm(ks[0], (BATCH, SEQ, d), 1.0),
        'x_sample': nrm(ks[1], (DEC_BATCH, DEC_SEQ, d), 1.0),
        'cache_swa_k': nrm(ks[2], (L, DEC_BATCH, w_buf, SWA_KV_HEADS, SWA_HEAD_DIM), 1.0),
        'cache_swa_v': nrm(ks[3], (L, DEC_BATCH, w_buf, SWA_KV_HEADS, SWA_HEAD_DIM), 1.0),
        'state_mlstm_C': nrm(ks[4], (L, DEC_BATCH, MLSTM_HEADS, hd, hd), 0.1),
        'state_mlstm_n': nrm(ks[5], (L, DEC_BATCH, MLSTM_HEADS, hd), 0.1),
        'state_mlstm_m': nrm(ks[6], (L, DEC_BATCH, MLSTM_HEADS), 1.0),
        'ffn1_norm': gain(ks[7], (L, d)),
        'ffn1_w_gate': nrm(ks[8], (L, d, D_FF), d ** -0.5),
        'ffn1_w_up': nrm(ks[9], (L, d, D_FF), d ** -0.5),
        'ffn1_w_down': nrm(ks[10], (L, D_FF, d), D_FF ** -0.5),
        'mix_norm': gain(ks[11], (L, d)),
        'w_in': nrm(ks[12], (L, d, PROJ_WIDTH), d ** -0.5),
        'mlstm_b_i': nrm(ks[13], (L, MLSTM_HEADS), 0.1),
        'mlstm_b_f': jnp.broadcast_to(jnp.linspace(3.0, 6.0, MLSTM_HEADS, dtype=f32), (L, MLSTM_HEADS)) + nrm(ks[14], (L, MLSTM_HEADS), 0.01),
        'mlstm_out_norm': gain(ks[15], (L, MLSTM_WIDTH)),
        'swa_q_norm': gain(ks[16], (L, SWA_HEAD_DIM)),
        'swa_k_norm': gain(ks[17], (L, SWA_HEAD_DIM)),
        'swa_sinks': nrm(ks[18], (L, SWA_HEADS), 0.5),
        'w_out': nrm(ks[19], (L, MIX_WIDTH, d), MIX_WIDTH ** -0.5),
        'ffn2_norm': gain(ks[20], (L, d)),
        'ffn2_w_gate': nrm(ks[21], (L, d, D_FF), d ** -0.5),
        'ffn2_w_up': nrm(ks[22], (L, d, D_FF), d ** -0.5),
        'ffn2_w_down': nrm(ks[23], (L, D_FF, d), D_FF ** -0.5),
    }


def reference(x_prompt, x_sample, cache_swa_k, cache_swa_v, state_mlstm_C, state_mlstm_n, state_mlstm_m,
              ffn1_norm, ffn1_w_gate, ffn1_w_up, ffn1_w_down, mix_norm, w_in, mlstm_b_i, mlstm_b_f,
              mlstm_out_norm, swa_q_norm, swa_k_norm, swa_sinks, w_out, ffn2_norm, ffn2_w_gate,
              ffn2_w_up, ffn2_w_down):
    yp, ys = x_prompt, x_sample
    bp = x_prompt.shape[0]
    pk, pv, pc, pn, pm = [], [], [], [], []
    sk, sv, sc, sn, sm = [], [], [], [], []
    for l in range(DEPTH):
        p = {
            'ffn1_norm': ffn1_norm[l], 'ffn1_w_gate': ffn1_w_gate[l], 'ffn1_w_up': ffn1_w_up[l],
            'ffn1_w_down': ffn1_w_down[l], 'mix_norm': mix_norm[l], 'w_in': w_in[l],
            'mlstm_b_i': mlstm_b_i[l], 'mlstm_b_f': mlstm_b_f[l], 'mlstm_out_norm': mlstm_out_norm[l],
            'swa_q_norm': swa_q_norm[l], 'swa_k_norm': swa_k_norm[l], 'swa_sinks': swa_sinks[l],
            'w_out': w_out[l], 'ffn2_norm': ffn2_norm[l], 'ffn2_w_gate': ffn2_w_gate[l],
            'ffn2_w_up': ffn2_w_up[l], 'ffn2_w_down': ffn2_w_down[l],
        }
        c0 = jnp.zeros((bp, MLSTM_HEADS, MLSTM_HEAD_DIM, MLSTM_HEAD_DIM), jnp.float32)
        n0 = jnp.zeros((bp, MLSTM_HEADS, MLSTM_HEAD_DIM), jnp.float32)
        m0 = jnp.zeros((bp, MLSTM_HEADS), jnp.float32)
        yp, (k1, v1, c1, n1, m1) = trunk_layer(yp, p, c0, n0, m0, None, None)
        ys, (k2, v2, c2, n2, m2) = trunk_layer(ys, p, state_mlstm_C[l], state_mlstm_n[l], state_mlstm_m[l],
                                               cache_swa_k[l], cache_swa_v[l])
        pk.append(k1); pv.append(v1); pc.append(c1); pn.append(n1); pm.append(m1)
        sk.append(k2); sv.append(v2); sc.append(c2); sn.append(n2); sm.append(m2)
    return (yp, ys, jnp.stack(pk), jnp.stack(pv), jnp.stack(pc), jnp.stack(pn), jnp.stack(pm),
            jnp.stack(sk), jnp.stack(sv), jnp.stack(sc), jnp.stack(sn), jnp.stack(sm))
```

```cpp
#include <hip/hip_runtime.h>
#include <hip/hip_cooperative_groups.h>
#include <cstdio>
namespace cg = cooperative_groups;

#define LAS __attribute__((address_space(3)))
typedef unsigned short bf16_t;
typedef short bf16x8 __attribute__((ext_vector_type(8)));
typedef short bf16x4 __attribute__((ext_vector_type(4)));
typedef float f32x4 __attribute__((ext_vector_type(4)));
typedef float f32x2 __attribute__((ext_vector_type(2)));
typedef __bf16 bfv2 __attribute__((ext_vector_type(2)));
typedef unsigned u32x4 __attribute__((ext_vector_type(4)));
typedef unsigned u32x2 __attribute__((ext_vector_type(2)));

#define DI __device__ __forceinline__

constexpr int TP = 16384, TS = 128, MV = TP + TS, MP = 16640;
constexpr int DM = 1024, FF = 2816, PW = 2816, WIN_LD = 2824;
constexpr float KSCALE = 0.08838834764831845f;
constexpr float EPS = 1e-6f;
constexpr int LDS_BYTES = 147456;

constexpr size_t AL(size_t x) { return (x + 255) & ~(size_t)255; }
constexpr size_t O_WGU1 = 0;
constexpr size_t O_WD1  = O_WGU1 + AL((size_t)2 * FF * DM * 2);
constexpr size_t O_WIN  = O_WD1 + AL((size_t)DM * FF * 2);
constexpr size_t O_WOUT = O_WIN + AL((size_t)PW * DM * 2);
constexpr size_t O_WGU2 = O_WOUT + AL((size_t)DM * DM * 2);
constexpr size_t O_WD2  = O_WGU2 + AL((size_t)2 * FF * DM * 2);
constexpr size_t O_XB   = O_WD2 + AL((size_t)DM * FF * 2);
constexpr size_t O_BIG  = O_XB + AL((size_t)MP * DM * 2);
constexpr size_t O_YMIX = O_BIG + AL((size_t)MP * FF * 2);
constexpr size_t O_CST  = O_YMIX + AL((size_t)MP * DM * 2);
constexpr size_t O_SSQ  = O_CST + AL((size_t)512 * 16384 * 2);
constexpr size_t O_GATE = O_SSQ + AL((size_t)16 * MP * 4);
constexpr size_t O_DN   = O_GATE + AL((size_t)MP * 8 * 4);
constexpr size_t O_NST  = O_DN + AL((size_t)512 * 128 * 4);
constexpr size_t O_ML   = O_NST + AL((size_t)512 * 128 * 4);
constexpr size_t O_BL   = O_ML + AL(512 * 4);
constexpr size_t O_MST  = O_BL + AL(512 * 4);
constexpr size_t WS_TOTAL = O_MST + AL(512 * 4);
static_assert(WS_TOTAL <= (size_t)256 * 1024 * 1024, "workspace too large");
static_assert((size_t)512 * 16384 * 4 <= (size_t)MP * DM * 2, "dC alias");

constexpr size_t OUT_Y = 0;
constexpr size_t OUT_PK = (size_t)MV * DM;
constexpr size_t OUT_PV = OUT_PK + 65536;
constexpr size_t OUT_PC = OUT_PV + 65536;
constexpr size_t OUT_PN = OUT_PC + 262144;
constexpr size_t OUT_PM = OUT_PN + 2048;
constexpr size_t OUT_SK = OUT_PM + 16;
constexpr size_t OUT_SV = OUT_SK + 2097152;
constexpr size_t OUT_SC = OUT_SV + 2097152;
constexpr size_t OUT_SN = OUT_SC + 8388608;
constexpr size_t OUT_SM = OUT_SN + 65536;

struct Params {
    const float *xp, *xs, *ck, *cv, *sC, *sn, *sm;
    const float *g1, *wg1, *wu1, *wd1, *gmix, *win, *bi, *bfg, *gout, *gq, *gk, *sinks, *wout, *g2, *wg2, *wu2, *wd2;
    float* out;
    unsigned char* ws;
};

DI size_t tm_off(size_t row, int col, int K) { return ((row >> 8) * (size_t)(K >> 6) + (size_t)(col >> 6)) * 16384 + (row & 255) * 64 + (col & 63); }
DI size_t pj(size_t row, int col);
DI unsigned pk_bf16(float a, float b) { f32x2 v = {a, b}; bfv2 r = __builtin_convertvector(v, bfv2); return __builtin_bit_cast(unsigned, r); }
DI float bf2f(short b) { return __uint_as_float(((unsigned)(unsigned short)b) << 16); }
DI short f2bf(float a) { return (short)(pk_bf16(a, 0.f) & 0xffffu); }
DI bf16x8 pack8(const float* f) { u32x4 p; p[0] = pk_bf16(f[0], f[1]); p[1] = pk_bf16(f[2], f[3]); p[2] = pk_bf16(f[4], f[5]); p[3] = pk_bf16(f[6], f[7]); return __builtin_bit_cast(bf16x8, p); }
DI float sigmoidf_(float x) { return 1.f / (1.f + __expf(-x)); }
#define MFMA16(a, b, c) __builtin_amdgcn_mfma_f32_16x16x32_bf16((a), (b), (c), 0, 0, 0)

namespace pg8 {
constexpr int BM = 256, BK = 64, HALF = 128, HTB = HALF * BK * 2, STAGE_BYTES = 8 * HTB, NXCD = 8, WGM = 8;
DI int lds_byte(int r, int c) { const int st = (r >> 4) * 2 + (c >> 5), rr = r & 15, cc = c & 31, ob = rr * 64 + cc * 2; return st * 1024 + (ob ^ (((ob >> 9) & 1) << 5)); }
DI void stage_rc(int b, int& R, int& C) { const int st = b / 1024, sb = b % 1024, swz = sb ^ (((sb >> 9) & 1) << 5); R = (st >> 1) * 16 + swz / 64; C = (st & 1) * 32 + (swz % 64) / 2; }
DI int perm32(int rho) { const int n = rho >> 4, i = rho & 15; return 8 * (i >> 2) + 4 * n + (i & 3); }
struct Unit { int pm, pn, ui, kt0, nt, kind; };
struct Gemm { const bf16_t* A; const bf16_t* A2; const bf16_t* Bt; int K; };
struct MixOrder {
    int nN, nwg, G, c, ntFull, sLo, sCnt, sKind, sNt;
    DI void init(int N, int K, int G_, int c_, int sLo_, int sCnt_, int sKind_, int sNt_) { nN = N / BM; nwg = 64 * nN; G = G_; c = c_; ntFull = K / BK; sLo = sLo_; sCnt = sCnt_; sKind = sKind_; sNt = sNt_; }
    DI bool next(int i, Unit& u) const {
        const bool hasS = (c >= sLo) && (c < sLo + sCnt);
        const bool isS = hasS && (i == 0);
        const int ii = hasS ? i - 1 : i;
        const long L = (long)ii * G + c;
        if (!isS && L >= nwg) return false;
        int wgid = isS ? 0 : (int)L; { const int q = nwg / NXCD, r = nwg % NXCD, xcd = wgid % NXCD, off = wgid / NXCD; wgid = (xcd < r ? xcd * (q + 1) : r * (q + 1) + (xcd - r) * q) + off; }
        const int nig = WGM * nN, gid = wgid / nig, fm = gid * WGM;
        const int ppm = fm + ((wgid % nig) % WGM), ppn = (wgid % nig) / WGM;
        const int idx = c - sLo;
        const int spn = (sKind == 1) ? idx : idx % nN, skt0 = (sKind == 1) ? 0 : (idx / nN) * sNt, snt = (sKind == 1) ? ntFull : sNt;
        Unit r;
        r.pm = isS ? 64 : ppm; r.pn = isS ? spn : ppn; r.ui = i; r.kt0 = isS ? skt0 : 0; r.nt = isS ? snt : ntFull; r.kind = isS ? sKind : 0;
        u = r;
        return true;
    }
    DI void a_ready(const Unit&) const {}
    DI void done(const Unit&) const {}
};

template <class Epi, class Sched>
DI void gemm_phase(LAS unsigned char* lds, const Gemm g, const Sched& S, const Epi& E) {
    const int tid = threadIdx.x, wid = __builtin_amdgcn_readfirstlane(tid >> 6), lane = tid & 63, wr = wid >> 2, wc = wid & 3, fr = lane & 15, fq = lane >> 4;
    const int K = g.K;
    unsigned voffA[2], voffB[2];
#pragma unroll
    for (int i = 0; i < 2; ++i) { int R, C; stage_rc(tid * 16 + i * 8192, R, C); const int Rb = Epi::PERM ? ((R & ~31) + perm32(R & 31)) : R;
        voffA[i] = (unsigned)(R * 64 + C) * 2u; voffB[i] = (unsigned)(Rb * 64 + C) * 2u; }
    const size_t kstep = (size_t)32768;
    const size_t hstep = (size_t)16384;
    const size_t tstep = (size_t)(K / BK) * kstep;
    const unsigned ldsw = (unsigned)wid * 1024u;
    const int aoff = lds_byte(wr * 64 + fr, fq * 8), boff = lds_byte(wc * 32 + fr, fq * 8);
#define PG8_SA(b, h) (((b) * 2 + (h)) * HTB)
#define PG8_SB(b, h) ((4 + (b) * 2 + (h)) * HTB)
#define PG8_STAGE(bufoff, gbase, voff) do { _Pragma("unroll") for (int _i = 0; _i < 2; ++_i) \
        __builtin_amdgcn_global_load_lds((const unsigned*)((const char*)(gbase) + (voff)[_i]), (LAS unsigned*)(lds + (bufoff) + ldsw + _i * 8192), 16, 0, 0); } while (0)
#define PG8_LDA(dst, b, h) do { _Pragma("unroll") for (int m = 0; m < 4; ++m) _Pragma("unroll") for (int k = 0; k < 2; ++k) dst[m][k] = *(const LAS bf16x8*)(lds + PG8_SA(b, h) + aoff + m * 2048 + k * 1024); } while (0)
#define PG8_LDB(dst, b, h) do { _Pragma("unroll") for (int n = 0; n < 2; ++n) _Pragma("unroll") for (int k = 0; k < 2; ++k) dst[n][k] = *(const LAS bf16x8*)(lds + PG8_SB(b, h) + boff + n * 2048 + k * 1024); } while (0)
#define PG8_MMA(ai, bj, At, Bt) do { __builtin_amdgcn_s_setprio(1); _Pragma("unroll") for (int m = 0; m < 4; ++m) _Pragma("unroll") for (int n = 0; n < 2; ++n) _Pragma("unroll") for (int k = 0; k < 2; ++k) \
        acc[ai][bj][m][n] = __builtin_amdgcn_mfma_f32_16x16x32_bf16(Bt[n][k], At[m][k], acc[ai][bj][m][n], 0, 0, 0); __builtin_amdgcn_s_setprio(0); } while (0)
#define PG8_WAIT_V(n) asm volatile("s_waitcnt vmcnt(" #n ")" ::: "memory")
#define PG8_WAIT_L(n) asm volatile("s_waitcnt lgkmcnt(" #n ")" ::: "memory")
#define PG8_BAR __builtin_amdgcn_s_barrier()
#define PG8_SCHED __builtin_amdgcn_sched_barrier(0)
    Unit cur, nxt; int ui = 0;
    if (!S.next(0, cur)) return;
    f32x4 acc[2][2][4][2];
#pragma unroll
    for (int a = 0; a < 2; ++a)
#pragma unroll
        for (int b = 0; b < 2; ++b)
#pragma unroll
            for (int m = 0; m < 4; ++m)
#pragma unroll
                for (int n = 0; n < 2; ++n) acc[a][b][m][n] = (f32x4){0.f, 0.f, 0.f, 0.f};
    bf16x8 At[4][2], B0[2][2], B1[2][2];
    const char* cA = (cur.kind ? (const char*)g.A2 : (const char*)g.A + (size_t)cur.pm * tstep) + (size_t)cur.kt0 * kstep; const char* cB = (const char*)g.Bt + (size_t)cur.pn * tstep + (size_t)cur.kt0 * kstep;
    S.a_ready(cur);
    PG8_STAGE(PG8_SB(0, 0), cB, voffB); PG8_STAGE(PG8_SA(0, 0), cA, voffA); PG8_STAGE(PG8_SB(0, 1), cB + hstep, voffB); PG8_STAGE(PG8_SA(0, 1), cA + hstep, voffA);
    if (wr == 1) PG8_BAR;
    PG8_WAIT_V(4); PG8_BAR;
    PG8_STAGE(PG8_SB(1, 0), cB + kstep, voffB); PG8_STAGE(PG8_SA(1, 0), cA + kstep, voffA); PG8_STAGE(PG8_SB(1, 1), cB + hstep + kstep, voffB);
    PG8_WAIT_V(6); PG8_BAR;
    for (;;) {
        const bool has_next = S.next(ui + 1, nxt);
        const char* nA = has_next ? (nxt.kind ? (const char*)g.A2 : (const char*)g.A + (size_t)nxt.pm * tstep) + (size_t)nxt.kt0 * kstep : cA; const char* nB = has_next ? (const char*)g.Bt + (size_t)nxt.pn * tstep + (size_t)nxt.kt0 * kstep : cB;
        const int nt = cur.nt;
        for (int t = 0; t < nt; t += 2) {
            const bool last = (t == nt - 2);
            const char* a1 = cA + (size_t)(t + 1) * kstep;
            const char* a2 = last ? nA : cA + (size_t)(t + 2) * kstep; const char* b2 = last ? nB : cB + (size_t)(t + 2) * kstep;
            const char* a3 = a2 + kstep; const char* b3 = b2 + kstep;
            if (last && has_next) S.a_ready(nxt);
            PG8_LDB(B0, 0, 0); PG8_SCHED; PG8_LDA(At, 0, 0); PG8_STAGE(PG8_SA(1, 1), a1 + hstep, voffA);
            PG8_WAIT_L(8); PG8_BAR; PG8_WAIT_L(0); PG8_MMA(0, 0, At, B0); PG8_BAR; PG8_SCHED;
            PG8_LDB(B1, 0, 1); PG8_STAGE(PG8_SB(0, 0), b2, voffB);
            PG8_BAR; PG8_WAIT_L(0); PG8_MMA(0, 1, At, B1); PG8_BAR;
            PG8_LDA(At, 0, 1); PG8_STAGE(PG8_SA(0, 0), a2, voffA);
            PG8_BAR; PG8_WAIT_L(0); PG8_MMA(1, 0, At, B0); PG8_BAR; PG8_SCHED;
            PG8_STAGE(PG8_SB(0, 1), b2 + hstep, voffB);
            PG8_WAIT_V(6); PG8_BAR; PG8_MMA(1, 1, At, B1); PG8_BAR;
            PG8_LDB(B0, 1, 0); PG8_SCHED; PG8_LDA(At, 1, 0); PG8_STAGE(PG8_SA(0, 1), a2 + hstep, voffA);
            PG8_WAIT_L(8); PG8_BAR; PG8_WAIT_L(0); PG8_MMA(0, 0, At, B0); PG8_BAR; PG8_SCHED;
            PG8_LDB(B1, 1, 1); PG8_STAGE(PG8_SB(1, 0), b3, voffB);
            PG8_BAR; PG8_WAIT_L(0); PG8_MMA(0, 1, At, B1); PG8_BAR;
            PG8_LDA(At, 1, 1); PG8_STAGE(PG8_SA(1, 0), a3, voffA);
            PG8_BAR; PG8_WAIT_L(0); PG8_MMA(1, 0, At, B0); PG8_BAR; PG8_SCHED;
            PG8_STAGE(PG8_SB(1, 1), b3 + hstep, voffB);
            PG8_WAIT_V(6); PG8_BAR; PG8_MMA(1, 1, At, B1); PG8_BAR;
        }
        E(acc, cur, wr, wc, fr, fq); S.done(cur);
        if (!has_next) break;
#pragma unroll
        for (int a = 0; a < 2; ++a)
#pragma unroll
            for (int b = 0; b < 2; ++b)
#pragma unroll
                for (int m = 0; m < 4; ++m)
#pragma unroll
                    for (int n = 0; n < 2; ++n) acc[a][b][m][n] = (f32x4){0.f, 0.f, 0.f, 0.f};
        cur = nxt; cA = nA; cB = nB; ++ui;
    }
    PG8_WAIT_V(0);
    if (wr == 0) PG8_BAR;
    PG8_BAR;
#undef PG8_SA
#undef PG8_SB
#undef PG8_STAGE
#undef PG8_LDA
#undef PG8_LDB
#undef PG8_MMA
#undef PG8_WAIT_V
#undef PG8_WAIT_L
#undef PG8_BAR
#undef PG8_SCHED
}
}
using pg8::Unit;

constexpr int RSL_OFF = 131072;
template <class Sched> DI void prep_rstd(unsigned char* smem, const float* __restrict__ ssq, int np, const Sched& S, const void* conv) {
    float* rsl = (float*)(smem + RSL_OFF);
    int* upm = (int*)(smem + RSL_OFF + 8 * 256 * 4);
    const int tid = threadIdx.x, lane = tid & 63, wid = tid >> 6;
    int nu = 0;
    {
        Unit u;
#pragma unroll 1
        for (int i = 0; i < 8 && S.next(i, u); ++i) {
            const bool cv = (u.kind == 1) && (conv != nullptr);
            if (tid == 0) upm[i] = cv ? -1 : u.pm;
            if (cv) {
                const bf16_t* xbs = (const bf16_t*)conv;
#pragma unroll 8
                for (int rr = 0; rr < 16; ++rr) {
                    const int r = rr * 8 + wid;
                    const bf16_t* src = xbs + tm_off((size_t)TP + r, 16 * lane, DM);
                    const bf16x8 v0 = *(const bf16x8*)src, v1 = *(const bf16x8*)(src + 8);
                    float ss = 0.f;
#pragma unroll
                    for (int e = 0; e < 8; ++e) { const float x0 = bf2f(v0[e]), x1 = bf2f(v1[e]); ss += x0 * x0 + x1 * x1; }
#pragma unroll
                    for (int o = 32; o >= 1; o >>= 1) ss += __shfl_xor(ss, o);
                    if (lane == 0) rsl[i * 256 + r] = rsqrtf(ss * (1.f / DM) + EPS);
                }
                if (tid < 128) rsl[i * 256 + 128 + tid] = 0.f;
            }
            nu = i + 1;
        }
    }
    __syncthreads();
    if (np == 16) {
        for (int idx = tid; idx < nu * 256; idx += 512) {
            const int i = idx >> 8, r = idx & 255, pm = upm[i];
            if (pm < 0) continue;
            const float* p = ssq + (size_t)pm * 256 + r;
            float v[16];
#pragma unroll
            for (int q = 0; q < 16; ++q) v[q] = p[(size_t)q * MP];
            float s = 0.f;
#pragma unroll
            for (int q = 0; q < 16; ++q) s += v[q];
            rsl[idx] = rsqrtf(s * (1.f / DM) + EPS);
        }
    } else {
        for (int idx = tid; idx < nu * 256; idx += 512) {
            const int i = idx >> 8, r = idx & 255, pm = upm[i];
            if (pm < 0) continue;
            rsl[idx] = rsqrtf(ssq[(size_t)pm * 256 + r] * (1.f / DM) + EPS);
        }
    }
    __syncthreads();
    asm volatile("" ::: "memory");
}
struct EpiSwiGLU {
    static constexpr bool PERM = true;
    bf16_t* act; const LAS float* rsl;
    DI void operator()(const f32x4 (&acc)[2][2][4][2], const Unit& u, int wr, int wc, int fr, int fq) const {
        const int row0 = u.pm * 256 + wr * 64 + fr, col0 = u.pn * 128 + wc * 32 + 8 * fq;
#pragma unroll
        for (int ai = 0; ai < 2; ++ai)
#pragma unroll
            for (int m = 0; m < 4; ++m) {
                const int row = row0 + ai * 128 + m * 16; const float rs = rsl[u.ui * 256 + wr * 64 + fr + ai * 128 + m * 16];
                float o[8];
#pragma unroll
                for (int n = 0; n < 2; ++n)
#pragma unroll
                    for (int i = 0; i < 4; ++i) { const float gv = acc[ai][0][m][n][i] * rs, uv = acc[ai][1][m][n][i] * rs; o[n * 4 + i] = gv * __builtin_amdgcn_rcpf(1.f + __expf(-gv)) * uv; }
                *(bf16x8*)(act + tm_off(row, col0, FF)) = pack8(o);
                asm volatile("" ::: "memory");
            }
    }
};
struct EpiRowScale {
    static constexpr bool PERM = true;
    bf16_t* O; int ldo; const LAS float* rsl;
    DI void operator()(const f32x4 (&acc)[2][2][4][2], const Unit& u, int wr, int wc, int fr, int fq) const {
        const int row0 = u.pm * 256 + wr * 64 + fr, col0 = u.pn * 256 + wc * 32 + 8 * fq;
#pragma unroll
        for (int ai = 0; ai < 2; ++ai)
#pragma unroll
            for (int m = 0; m < 4; ++m) {
                const int row = row0 + ai * 128 + m * 16; const float rs = rsl[u.ui * 256 + wr * 64 + fr + ai * 128 + m * 16];
#pragma unroll
                for (int bj = 0; bj < 2; ++bj) {
                    float o[8];
#pragma unroll
                    for (int n = 0; n < 2; ++n)
#pragma unroll
                        for (int i = 0; i < 4; ++i) o[n * 4 + i] = acc[ai][bj][m][n][i] * rs;
                    *(bf16x8*)(O + pj(row, col0 + bj * 128)) = pack8(o);
                }
                asm volatile("" ::: "memory");
            }
    }
};
template <bool LAST> struct EpiResid {
    static constexpr bool PERM = false;
    float* out; float scale; bf16_t* xb; float* ssqp;
    DI void operator()(const f32x4 (&acc)[2][2][4][2], const Unit& u, int wr, int wc, int fr, int fq) const {
        const int col0 = u.pn * 256 + wc * 32 + 4 * fq;
        if (u.kind == 2) {
#pragma unroll
            for (int m = 0; m < 4; ++m) {
                float* op = out + (size_t)(TP + wr * 64 + m * 16 + fr) * DM + col0;
#pragma unroll
                for (int bj = 0; bj < 2; ++bj)
#pragma unroll
                    for (int n = 0; n < 2; ++n)
#pragma unroll
                        for (int i = 0; i < 4; ++i) __hip_atomic_fetch_add(op + bj * 128 + n * 16 + i, scale * acc[0][bj][m][n][i], __ATOMIC_RELAXED, __HIP_MEMORY_SCOPE_AGENT);
                asm volatile("" ::: "memory");
            }
            return;
        }
        const int row0 = u.pm * 256 + wr * 64 + fr;
#pragma unroll
        for (int ai = 0; ai < 2; ++ai) {
            bf16x4 rb[4][2][2];
#pragma unroll
            for (int m = 0; m < 4; ++m)
#pragma unroll
                for (int bj = 0; bj < 2; ++bj)
#pragma unroll
                    for (int n = 0; n < 2; ++n) { const bf16x4* rp4 = (const bf16x4*)(xb + tm_off(row0 + ai * 128 + m * 16, col0 + bj * 128 + n * 16, DM)); rb[m][bj][n] = LAST ? __builtin_nontemporal_load(rp4) : *rp4; }
#pragma unroll
            for (int m = 0; m < 4; ++m) {
                const int row = row0 + ai * 128 + m * 16;
                float ss = 0.f;
#pragma unroll
                for (int bj = 0; bj < 2; ++bj)
#pragma unroll
                    for (int n = 0; n < 2; ++n) {
                        const int c = col0 + bj * 128 + n * 16;
                        bf16_t* xp4 = xb + tm_off(row, c, DM);
                        const bf16x4 r4 = rb[m][bj][n];
                        const f32x4 r = {bf2f(r4[0]), bf2f(r4[1]), bf2f(r4[2]), bf2f(r4[3])};
                        const f32x4 o = r + scale * acc[ai][bj][m][n];
                        if (LAST) *(f32x4*)(out + (size_t)row * DM + c) = o;
                        else { ss += o[0] * o[0] + o[1] * o[1] + o[2] * o[2] + o[3] * o[3];
                            u32x2 pk; pk[0] = pk_bf16(o[0], o[1]); pk[1] = pk_bf16(o[2], o[3]); *(u32x2*)xp4 = pk; }
                    }
                if (!LAST) { ss += __shfl_xor(ss, 16); ss += __shfl_xor(ss, 32); if (fq == 0) ssqp[(size_t)(u.pn * 4 + wc) * MP + row] = ss; }
            }
            asm volatile("" ::: "memory");
        }
    }
};

DI void convert_unit(float* tl, const float* __restrict__ W, int ldw, int k0, int srccol0, const float* __restrict__ gain, bf16_t* __restrict__ Wt, int ldk, int dstrow0) {
    const int tid = threadIdx.x;
    f32x4 v[8]; float g[8];
#pragma unroll
    for (int i = 0; i < 8; ++i) {
        const int kk = (tid >> 4) + 32 * i, c4 = (tid & 15) * 4;
        v[i] = __builtin_nontemporal_load((const f32x4*)(W + (size_t)(k0 + kk) * ldw + srccol0 + c4));
        g[i] = gain ? gain[k0 + kk] : 1.f;
    }
#pragma unroll
    for (int i = 0; i < 8; ++i) {
        const int kk = (tid >> 4) + 32 * i, c4 = (tid & 15) * 4;
#pragma unroll
        for (int j = 0; j < 4; ++j) tl[kk * 65 + c4 + j] = v[i][j] * g[i];
    }
    __syncthreads();
#pragma unroll
    for (int i = 0; i < 4; ++i) {
        const int id = tid + 512 * i, n = id & 63, kc = (id >> 6) * 8; float f[8];
#pragma unroll
        for (int e = 0; e < 8; ++e) f[e] = tl[(kc + e) * 65 + n];
        *(bf16x8*)(Wt + tm_off(dstrow0 + n, k0 + kc, ldk)) = pack8(f);
    }
    __syncthreads();
}
DI void convert_weight_unit(const Params& P, float* tl, int id) {
    if (id < 352 || (id >= 768 && id < 1120)) {
        const bool second = id >= 768; if (second) id -= 768;
        const int ntile = id % 88, kt = id / 88, dstrow0 = ntile * 64, pn = dstrow0 >> 8, hh = (dstrow0 >> 7) & 1, j0 = dstrow0 & 127;
        const float* W = second ? (hh ? P.wu2 : P.wg2) : (hh ? P.wu1 : P.wg1);
        convert_unit(tl, W, FF, kt * 256, pn * 128 + j0, second ? P.g2 : P.g1, (bf16_t*)(P.ws + (second ? O_WGU2 : O_WGU1)), DM, dstrow0);
    } else if (id < 528 || id >= 1120) {
        const bool second = id >= 1120; id -= second ? 1120 : 352;
        const int ntile = id % 16, kt = id / 16;
        convert_unit(tl, second ? P.wd2 : P.wd1, DM, kt * 256, ntile * 64, nullptr, (bf16_t*)(P.ws + (second ? O_WD2 : O_WD1)), FF, ntile * 64);
    } else if (id < 704) {
        id -= 528; const int ntile = id % 44, kt = id / 44, dstrow0 = ntile * 64;
        convert_unit(tl, P.win, WIN_LD, kt * 256, dstrow0 < 2048 ? dstrow0 : dstrow0 + 8, P.gmix, (bf16_t*)(P.ws + O_WIN), DM, dstrow0);
    } else {
        id -= 704; const int ntile = id % 16, kt = id / 16;
        convert_unit(tl, P.wout, DM, kt * 256, ntile * 64, nullptr, (bf16_t*)(P.ws + O_WOUT), DM, ntile * 64);
    }
}
struct WDesc { const float* W; const float* gain; bf16_t* Wt; int ldw, k0, srccol0, ldk, dstrow0; };
DI WDesc wdesc(const Params& P, int id) {
    WDesc d;
    if (id < 352 || (id >= 768 && id < 1120)) {
        const bool second = id >= 768; if (second) id -= 768;
        const int ntile = id % 88, kt = id / 88, dstrow0 = ntile * 64, pn = dstrow0 >> 8, hh = (dstrow0 >> 7) & 1, j0 = dstrow0 & 127;
        d.W = second ? (hh ? P.wu2 : P.wg2) : (hh ? P.wu1 : P.wg1); d.gain = second ? P.g2 : P.g1; d.Wt = (bf16_t*)(P.ws + (second ? O_WGU2 : O_WGU1));
        d.ldw = FF; d.k0 = kt * 256; d.srccol0 = pn * 128 + j0; d.ldk = DM; d.dstrow0 = dstrow0;
    } else if (id < 528 || id >= 1120) {
        const bool second = id >= 1120; id -= second ? 1120 : 352;
        const int ntile = id % 16, kt = id / 16;
        d.W = second ? P.wd2 : P.wd1; d.gain = nullptr; d.Wt = (bf16_t*)(P.ws + (second ? O_WD2 : O_WD1)); d.ldw = DM; d.k0 = kt * 256; d.srccol0 = ntile * 64; d.ldk = FF; d.dstrow0 = ntile * 64;
    } else if (id < 704) {
        id -= 528; const int ntile = id % 44, kt = id / 44, dstrow0 = ntile * 64;
        d.W = P.win; d.gain = P.gmix; d.Wt = (bf16_t*)(P.ws + O_WIN); d.ldw = WIN_LD; d.k0 = kt * 256; d.srccol0 = dstrow0 < 2048 ? dstrow0 : dstrow0 + 8; d.ldk = DM; d.dstrow0 = dstrow0;
    } else {
        id -= 704; const int ntile = id % 16, kt = id / 16;
        d.W = P.wout; d.gain = nullptr; d.Wt = (bf16_t*)(P.ws + O_WOUT); d.ldw = DM; d.k0 = kt * 256; d.srccol0 = ntile * 64; d.ldk = DM; d.dstrow0 = ntile * 64;
    }
    return d;
}
DI void p0_load(const Params& P, int t, int nW, f32x4 (&v)[8], float (&g)[8]) {
    const int tid = threadIdx.x, lane = tid & 63, wid = tid >> 6;
    if (t < nW) {
        const WDesc d = wdesc(P, t);
#pragma unroll
        for (int i = 0; i < 8; ++i) {
            const int kk = (tid >> 4) + 32 * i, c4 = (tid & 15) * 4;
            v[i] = __builtin_nontemporal_load((const f32x4*)(d.W + (size_t)(d.k0 + kk) * d.ldw + d.srccol0 + c4));
            g[i] = d.gain ? d.gain[d.k0 + kk] : 1.f;
        }
    } else {
        const int id = t - nW;
#pragma unroll
        for (int rr = 0; rr < 2; ++rr) {
            const int row = id * 16 + rr * 8 + wid;
            const float* src = row < TP ? P.xp + (size_t)row * DM : P.xs + (size_t)(row - TP) * DM;
#pragma unroll
            for (int i = 0; i < 4; ++i) v[rr * 4 + i] = __builtin_nontemporal_load((const f32x4*)(src + i * 256 + lane * 4));
        }
    }
}
DI void p0_proc(const Params& P, float* tl, int t, int nW, const f32x4 (&v)[8], const float (&g)[8]) {
    const int tid = threadIdx.x, lane = tid & 63, wid = tid >> 6;
    if (t < nW) {
        const WDesc d = wdesc(P, t);
#pragma unroll
        for (int i = 0; i < 8; ++i) {
            const int kk = (tid >> 4) + 32 * i, c4 = (tid & 15) * 4;
#pragma unroll
            for (int j = 0; j < 4; ++j) tl[kk * 65 + c4 + j] = v[i][j] * g[i];
        }
        __syncthreads();
#pragma unroll
        for (int i = 0; i < 4; ++i) {
            const int id = tid + 512 * i, n = id & 63, kc = (id >> 6) * 8; float f[8];
#pragma unroll
            for (int e = 0; e < 8; ++e) f[e] = tl[(kc + e) * 65 + n];
            *(bf16x8*)(d.Wt + tm_off(d.dstrow0 + n, d.k0 + kc, d.ldk)) = pack8(f);
        }
        __syncthreads();
    } else {
        bf16_t* xb = (bf16_t*)(P.ws + O_XB); float* ssq = (float*)(P.ws + O_SSQ);
        const int id = t - nW;
#pragma unroll
        for (int rr = 0; rr < 2; ++rr) {
            const int row = id * 16 + rr * 8 + wid;
            float ss = 0.f;
#pragma unroll
            for (int i = 0; i < 4; ++i) {
                const f32x4 x = v[rr * 4 + i];
                ss += x[0] * x[0] + x[1] * x[1] + x[2] * x[2] + x[3] * x[3];
                u32x2 pk; pk[0] = pk_bf16(x[0], x[1]); pk[1] = pk_bf16(x[2], x[3]);
                *(u32x2*)(xb + tm_off(row, i * 256 + lane * 4, DM)) = pk;
                if (row >= TP) *(f32x4*)(P.out + (size_t)row * DM + i * 256 + lane * 4) = x;
            }
#pragma unroll
            for (int o = 32; o >= 1; o >>= 1) ss += __shfl_xor(ss, o);
            if (lane == 0) ssq[row] = ss;
        }
    }
}
DI void phase0(const Params& P, unsigned char* smem) {
    float* tl = (float*)smem;
    const int nW = (gridDim.x == 256) ? 352 : 1296, N = nW + 1032, G = gridDim.x;
    f32x4 va[8], vb[8]; float ga[8], gb[8];
    int t = blockIdx.x;
    if (t < N) p0_load(P, t, nW, va, ga);
    while (t < N) {
        int t2 = t + G;
        if (t2 < N) p0_load(P, t2, nW, vb, gb);
        p0_proc(P, tl, t, nW, va, ga);
        t = t2; if (t >= N) break;
        t2 = t + G;
        if (t2 < N) p0_load(P, t2, nW, va, ga);
        p0_proc(P, tl, t, nW, vb, gb);
        t = t2;
    }
}

DI void gates_pass(const Params& P, unsigned char* smem) {
    bf16_t* wg = (bf16_t*)smem;
    float* lss = (float*)(smem + 16 * 1032 * 2);
    const int tid = threadIdx.x, lane = tid & 63, wid = tid >> 6, fr = lane & 15, fq = lane >> 4;
#pragma unroll
    for (int j = 0; j < 2; ++j) {
        const int k = tid + 512 * j; const float g = P.gmix[k];
        const f32x4 v0 = *(const f32x4*)(P.win + (size_t)k * WIN_LD + 2048), v1 = *(const f32x4*)(P.win + (size_t)k * WIN_LD + 2052);
#pragma unroll
        for (int n = 0; n < 4; ++n) { wg[n * 1032 + k] = (bf16_t)f2bf(v0[n] * g); wg[(4 + n) * 1032 + k] = (bf16_t)f2bf(v1[n] * g); }
#pragma unroll
        for (int n = 8; n < 16; ++n) wg[n * 1032 + k] = (bf16_t)0;
    }
    __syncthreads();
    float* gates = (float*)(P.ws + O_GATE);
    const bf16_t* xb = (const bf16_t*)(P.ws + O_XB);
    for (int tile = blockIdx.x * 8 + wid; tile < MV / 16; tile += gridDim.x * 8) {
        const int row = tile * 16 + fr;
        f32x4 acc = {0.f, 0.f, 0.f, 0.f}; float ss = 0.f;
        if (true) {
            const bf16_t* src = xb + tm_off(row, 0, DM) + 8 * fq;
#pragma unroll 16
            for (int ks = 0; ks < 32; ++ks) {
                const bf16x8 a = *(const bf16x8*)(src + (size_t)(ks >> 1) * 16384 + (ks & 1) * 32);
                const bf16x8 bw = *(const bf16x8*)(wg + fr * 1032 + 32 * ks + 8 * fq);
#pragma unroll
                for (int e = 0; e < 8; ++e) { const float x = bf2f(a[e]); ss += x * x; }
                acc = MFMA16(a, bw, acc);
            }
        } else {
            const float* src = P.out + (size_t)row * DM + 8 * fq;
#pragma unroll 4
            for (int ks = 0; ks < 32; ++ks) {
                const f32x4 x0 = *(const f32x4*)(src + 32 * ks), x1 = *(const f32x4*)(src + 32 * ks + 4);
                float f[8] = {x0[0], x0[1], x0[2], x0[3], x1[0], x1[1], x1[2], x1[3]};
#pragma unroll
                for (int e = 0; e < 8; ++e) ss += f[e] * f[e];
                const bf16x8 a = pack8(f);
                const bf16x8 bw = *(const bf16x8*)(wg + fr * 1032 + 32 * ks + 8 * fq);
                acc = MFMA16(a, bw, acc);
            }
        }
        ss += __shfl_xor(ss, 16); ss += __shfl_xor(ss, 32);
        if (fq == 0) lss[wid * 16 + fr] = rsqrtf(ss * (1.f / DM) + EPS);
        if (fr < 8) {
            const float bias = (fr < 4) ? P.bi[fr] : P.bfg[fr - 4];
#pragma unroll
            for (int r = 0; r < 4; ++r) {
                const float v = acc[r] * lss[wid * 16 + 4 * fq + r] + bias;
                const float o = (fr < 4) ? v : (fminf(v, 0.f) - log1pf(expf(-fabsf(v))));
                gates[(size_t)(tile * 16 + 4 * fq + r) * 8 + fr] = o;
            }
        }
    }
    __syncthreads();
}

DI size_t pj(size_t row, int col) {
    return col < 2048 ? ((size_t)(col >> 7) * MP + row) * 128 + (col & 127)
                      : (size_t)16 * MP * 128 + ((size_t)((col - 2048) >> 6) * MP + row) * 64 + (col & 63);
}
constexpr int C_QM = 0, C_KM = 512, C_VM = 1024, C_OM = 1536, C_QA = 2048, C_KA = 2560, C_VA = 2688;

DI float cumsum128(float v, float* red) {
    const int tid = threadIdx.x, lane = tid & 63;
    float cs = v;
#pragma unroll
    for (int o = 1; o < 64; o <<= 1) { const float t = __shfl_up(cs, o); if (lane >= o) cs += t; }
    if (tid == 63) red[0] = cs;
    __syncthreads();
    if (tid >= 64 && tid < 128) cs += red[0];
    __syncthreads();
    return cs;
}
DI float cummax128(float v, float* red) {
    const int tid = threadIdx.x, lane = tid & 63;
    float cs = v;
#pragma unroll
    for (int o = 1; o < 64; o <<= 1) { const float t = __shfl_up(cs, o); if (lane >= o) cs = fmaxf(cs, t); }
    if (tid == 63) red[0] = cs;
    __syncthreads();
    if (tid >= 64 && tid < 128) cs = fmaxf(cs, red[0]);
    __syncthreads();
    return cs;
}

template <int V> DI void m1_item(const Params& P, unsigned char* smem, int item) {
    const int tid = threadIdx.x, lane = tid & 63, wid = tid >> 6, fr = lane & 15, fq = lane >> 4;
    const int c = item & 31, bh = item >> 5, h = bh & 3, b = bh >> 2;
    const size_t row0 = (size_t)b * 4096 + c * 128;
    const bf16_t* proj = (const bf16_t*)(P.ws + O_BIG);
    const float* gates = (const float*)(P.ws + O_GATE);
    bf16_t* Vt = (bf16_t*)smem;
    bf16_t* Kt = Vt + 128 * 136;
    float* fw = (float*)(smem + 2 * 128 * 136 * 2);
    float* red = fw + 128;
    float ip = 0.f, lf = 0.f;
    if (tid < 128) { ip = gates[(row0 + tid) * 8 + h]; lf = gates[(row0 + tid) * 8 + 4 + h]; }
    bf16x8 kreg[4], vreg[4];
#pragma unroll
    for (int i = 0; i < 4; ++i) {
        const int s = tid & 127, dg = (tid >> 7) + 4 * i;
        kreg[i] = *(const bf16x8*)(proj + pj(row0 + s, C_KM + h * 128 + dg * 8));
        vreg[i] = *(const bf16x8*)(proj + pj(row0 + s, C_VM + h * 128 + dg * 8));
    }
    const float cs = cumsum128(lf, red);
    if (tid == 127) red[1] = cs;
    __syncthreads();
    const float blast = red[1];
    const float le = (tid < 128) ? blast - cs + ip : -INFINITY;
    float mx = le;
#pragma unroll
    for (int o = 32; o >= 1; o >>= 1) mx = fmaxf(mx, __shfl_xor(mx, o));
    if (lane == 0 && wid < 2) red[2 + wid] = mx;
    __syncthreads();
    const float mloc = fmaxf(red[2], red[3]);
    if (tid < 128) fw[tid] = __expf(le - mloc);
    __syncthreads();
#pragma unroll
    for (int i = 0; i < 4; ++i) {
        const int s = tid & 127, dg = (tid >> 7) + 4 * i;
        const bf16x8 kv = kreg[i], vv = vreg[i];
        const float w = fw[s];
#pragma unroll
        for (int e = 0; e < 8; ++e) { Kt[(dg * 8 + e) * 136 + s] = kv[e]; Vt[(dg * 8 + e) * 136 + s] = f2bf(bf2f(vv[e]) * w); }
    }
    __syncthreads();
    if (V == 1) { __syncthreads(); return; }
    f32x4 acc[8];
#pragma unroll
    for (int kt = 0; kt < 8; ++kt) acc[kt] = (f32x4){0.f, 0.f, 0.f, 0.f};
#pragma unroll
    for (int ss = 0; ss < 4; ++ss) {
        const bf16x8 bfrag = *(const bf16x8*)(Vt + (16 * wid + fr) * 136 + 32 * ss + 8 * fq);
#pragma unroll
        for (int kt = 0; kt < 8; ++kt) {
            const bf16x8 afrag = *(const bf16x8*)(Kt + (16 * kt + fr) * 136 + 32 * ss + 8 * fq);
            acc[kt] = MFMA16(afrag, bfrag, acc[kt]);
        }
    }
    bf16_t* dC = (bf16_t*)P.out + (size_t)item * 16384;
#pragma unroll
    for (int kt = 0; kt < 8; ++kt) { const f32x4 a = acc[kt] * KSCALE; u32x2 pk; pk[0] = pk_bf16(a[0], a[1]); pk[1] = pk_bf16(a[2], a[3]);
        *(u32x2*)(dC + (16 * wid + fr) * 128 + 16 * kt + 4 * fq) = pk; }
    { const int k = tid >> 2, part = tid & 3; float sum = 0.f;
      for (int s = 32 * part; s < 32 * part + 32; ++s) sum += fw[s] * bf2f(Kt[k * 136 + s]);
      sum += __shfl_xor(sum, 1); sum += __shfl_xor(sum, 2);
      if (part == 0) ((float*)(P.ws + O_DN))[(size_t)item * 128 + k] = sum * KSCALE; }
    if (tid == 0) { ((float*)(P.ws + O_ML))[item] = mloc; ((float*)(P.ws + O_BL))[item] = blast; }
    __syncthreads();
}

DI void scan_phase(const Params& P, unsigned char* smem) {
    const bf16_t* __restrict__ dC = (const bf16_t*)P.out;
    const float* __restrict__ dn = (const float*)(P.ws + O_DN);
    const float* __restrict__ ml = (const float*)(P.ws + O_ML);
    const float* __restrict__ bl = (const float*)(P.ws + O_BL);
    bf16_t* __restrict__ cst = (bf16_t*)(P.ws + O_CST);
    float* __restrict__ nst = (float*)(P.ws + O_NST);
    float* __restrict__ mst = (float*)(P.ws + O_MST);
    float* ldec = (float*)smem; float* lwi = ldec + 32;
    const int tid = threadIdx.x;
    for (int blk = blockIdx.x; blk < 256; blk += gridDim.x) {
        const int bh = blk >> 4;
        if (tid < 32) { ldec[64 + tid] = bl[bh * 32 + tid]; ldec[96 + tid] = ml[bh * 32 + tid]; }
        __syncthreads();
        if (tid == 0) {
            float m = 0.f;
            for (int c = 0; c < 32; ++c) {
                const int item = bh * 32 + c; const float blc = ldec[64 + c], mlc = ldec[96 + c];
                const float mn = fmaxf(blc + m, mlc);
                ldec[c] = __expf(blc + m - mn); lwi[c] = __expf(mlc - mn);
                if ((blk & 15) == 0) mst[item] = m;
                m = mn;
            }
            if ((blk & 15) == 0) P.out[OUT_PM + bh] = m;
        }
        __syncthreads();
        {
            const int e2 = (blk & 15) * 1024 + tid * 2;
            const bf16_t* src = dC + (size_t)bh * 32 * 16384 + e2;
            bf16_t* dst = cst + (size_t)bh * 32 * 16384 + e2;
            f32x2 C = {0.f, 0.f};
#pragma unroll 1
            for (int c0 = 0; c0 < 32; c0 += 8) {
                f32x2 d[8];
#pragma unroll
                for (int j = 0; j < 8; ++j) { const unsigned w = __builtin_nontemporal_load((const unsigned*)(src + (size_t)(c0 + j) * 16384)); d[j][0] = __uint_as_float(w << 16); d[j][1] = __uint_as_float(w & 0xffff0000u); }
#pragma unroll
                for (int j = 0; j < 8; ++j) {
                    *(unsigned*)(dst + (size_t)(c0 + j) * 16384) = pk_bf16(C[0], C[1]);
                    C = ldec[c0 + j] * C + lwi[c0 + j] * d[j];
                }
            }
            *(f32x2*)(P.out + OUT_PC + (size_t)bh * 16384 + e2) = C;
        }
        if ((blk & 15) == 1 && tid < 128) {
            float n = 0.f;
#pragma unroll 1
            for (int c0 = 0; c0 < 32; c0 += 8) {
                float d[8];
#pragma unroll
                for (int j = 0; j < 8; ++j) d[j] = dn[(size_t)(bh * 32 + c0 + j) * 128 + tid];
#pragma unroll
                for (int j = 0; j < 8; ++j) { nst[(size_t)(bh * 32 + c0 + j) * 128 + tid] = n; n = ldec[c0 + j] * n + lwi[c0 + j] * d[j]; }
            }
            P.out[OUT_PN + (size_t)bh * 128 + tid] = n;
        }
        __syncthreads();
    }
}

template <int V> DI void m3_item(const Params& P, unsigned char* smem, int item) {
    const int tid = threadIdx.x, lane = tid & 63, wid = __builtin_amdgcn_readfirstlane(tid >> 6), fr = lane & 15, fq = lane >> 4;
    const int c = item & 31, bh = item >> 5, h = bh & 3, b = bh >> 2;
    const size_t row0 = (size_t)b * 4096 + c * 128;
    const bf16_t* proj = (const bf16_t*)(P.ws + O_BIG);
    const float* gates = (const float*)(P.ws + O_GATE);
    bf16_t* Ks = (bf16_t*)smem;
    bf16_t* Vt = Ks + 128 * 136;
    bf16_t* C0 = Vt + 128 * 136;
    float* fb = (float*)(smem + 3 * 128 * 136 * 2);
    float* fg = fb + 128;
    float* fpm = fg + 128;
    float* fn = fpm + 128;
    float* red = fn + 128;
    float ip = 0.f, lf = 0.f, n0v = 0.f;
    if (tid < 128) { ip = gates[(row0 + tid) * 8 + h]; lf = gates[(row0 + tid) * 8 + 4 + h]; n0v = ((const float*)(P.ws + O_NST))[(size_t)item * 128 + tid]; }
    const float m0 = ((const float*)(P.ws + O_MST))[item];
    const bf16_t* cst = (const bf16_t*)(P.ws + O_CST) + (size_t)item * 16384;
    const int t = 16 * wid + fr; const size_t rowt = row0 + t;
    bf16x8 kreg[4], creg[4], vreg[4], Bq[4]; bf16x4 oreg[8];
#pragma unroll
    for (int i = 0; i < 4; ++i) {
        const int id = tid + 512 * i, s = id >> 4, ch = id & 15;
        kreg[i] = *(const bf16x8*)(proj + pj(row0 + s, C_KM + h * 128 + ch * 8));
        creg[i] = *(const bf16x8*)(cst + s * 128 + ch * 8);
        const int s2 = tid & 127, dg = (tid >> 7) + 4 * i;
        vreg[i] = *(const bf16x8*)(proj + pj(row0 + s2, C_VM + h * 128 + dg * 8));
    }
#pragma unroll
    for (int ks = 0; ks < 4; ++ks) Bq[ks] = *(const bf16x8*)(proj + pj(rowt, C_QM + h * 128 + 32 * ks + 8 * fq));
#pragma unroll
    for (int vt = 0; vt < 8; ++vt) oreg[vt] = *(const bf16x4*)(proj + pj(rowt, C_OM + h * 128 + 16 * vt + 4 * fq));
    const float cs = cumsum128(lf, red);
    const float gg = ip - cs;
    const float pm = cummax128(tid < 128 ? gg : -INFINITY, red);
    if (tid < 128) { fb[tid] = cs; fg[tid] = gg; fpm[tid] = pm; fn[tid] = n0v; }
#pragma unroll
    for (int i = 0; i < 4; ++i) {
        const int id = tid + 512 * i, s = id >> 4, ch = id & 15;
        *(bf16x8*)(Ks + s * 136 + ch * 8) = kreg[i];
        *(bf16x8*)(C0 + s * 136 + ch * 8) = creg[i];
        const int s2 = tid & 127, dg = (tid >> 7) + 4 * i;
#pragma unroll
        for (int e = 0; e < 8; ++e) Vt[(dg * 8 + e) * 136 + s2] = vreg[i][e];
    }
    __syncthreads();
    if (V == 1) { __syncthreads(); return; }
    float nq = 0.f;
#pragma unroll
    for (int ks = 0; ks < 4; ++ks)
#pragma unroll
        for (int e = 0; e < 8; ++e) nq += fn[32 * ks + 8 * fq + e] * bf2f(Bq[ks][e]);
    nq += __shfl_xor(nq, 16); nq += __shfl_xor(nq, 32);
    const float Mt = fmaxf(m0, fpm[t]); const float winter = __expf(m0 - Mt);
    f32x4 accP[8];
#pragma unroll
    for (int vt = 0; vt < 8; ++vt) accP[vt] = (f32x4){0.f, 0.f, 0.f, 0.f};
    {
        bf16x8 Bqs[4];
#pragma unroll
        for (int ks = 0; ks < 4; ++ks) { float f[8];
#pragma unroll
            for (int e = 0; e < 8; ++e) f[e] = bf2f(Bq[ks][e]) * winter;
            Bqs[ks] = pack8(f); }
#pragma unroll
        for (int ks = 0; ks < 4; ++ks) {
#pragma unroll
            for (int vt = 0; vt < 8; ++vt) {
                const bf16x8 a = *(const bf16x8*)(C0 + (16 * vt + fr) * 136 + 32 * ks + 8 * fq);
                accP[vt] = MFMA16(a, Bqs[ks], accP[vt]);
            }
            asm volatile("" ::: "memory");
        }
    }
    float psum = 0.f;
    const int npair = (wid >> 1) + 1;
#pragma unroll 1
    for (int p = 0; p < npair; ++p) {
        asm volatile("" ::: "memory");
        f32x4 S0 = {0.f, 0.f, 0.f, 0.f}, S1 = {0.f, 0.f, 0.f, 0.f};
#pragma unroll
        for (int ks = 0; ks < 4; ++ks) {
            const bf16x8 a0 = *(const bf16x8*)(Ks + (32 * p + fr) * 136 + 32 * ks + 8 * fq);
            const bf16x8 a1 = *(const bf16x8*)(Ks + (32 * p + 16 + fr) * 136 + 32 * ks + 8 * fq);
            S0 = MFMA16(a0, Bq[ks], S0); S1 = MFMA16(a1, Bq[ks], S1);
        }
        float pv[8];
#pragma unroll
        for (int r = 0; r < 4; ++r) {
            const int s0 = 32 * p + 4 * fq + r, s1 = s0 + 16;
            const float d0 = (s0 <= t) ? __expf(fg[s0] - Mt) : 0.f;
            const float d1 = (s1 <= t) ? __expf(fg[s1] - Mt) : 0.f;
            pv[r] = (s0 <= t) ? S0[r] * KSCALE * d0 : 0.f; pv[4 + r] = (s1 <= t) ? S1[r] * KSCALE * d1 : 0.f;
            psum += pv[r] + pv[4 + r];
        }
        const bf16x8 Bp = pack8(pv);
#pragma unroll
        for (int vt = 0; vt < 8; ++vt) {
            const bf16x4 lo = *(const bf16x4*)(Vt + (16 * vt + fr) * 136 + 32 * p + 4 * fq);
            const bf16x4 hi = *(const bf16x4*)(Vt + (16 * vt + fr) * 136 + 32 * p + 16 + 4 * fq);
            const bf16x8 a = {lo[0], lo[1], lo[2], lo[3], hi[0], hi[1], hi[2], hi[3]};
            accP[vt] = MFMA16(a, Bp, accP[vt]);
        }
    }
    psum += __shfl_xor(psum, 16); psum += __shfl_xor(psum, 32);
    const float den = winter * nq + psum, mt = fb[t] + Mt;
    const float inv = 1.f / fmaxf(fabsf(den), __expf(-mt));
    float ssq = 0.f;
#pragma unroll
    for (int vt = 0; vt < 8; ++vt)
#pragma unroll
        for (int r = 0; r < 4; ++r) { const float hv = accP[vt][r] * inv; accP[vt][r] = hv; ssq += hv * hv; }
    ssq += __shfl_xor(ssq, 16); ssq += __shfl_xor(ssq, 32);
    const float rn = rsqrtf(ssq * (1.f / 128.f) + EPS);
    bf16_t* ymix = (bf16_t*)(P.ws + O_YMIX);
#pragma unroll
    for (int vt = 0; vt < 8; ++vt) {
        const int v0 = 16 * vt + 4 * fq;
        const bf16x4 o4 = oreg[vt];
        const f32x4 g4 = *(const f32x4*)(P.gout + h * 128 + v0);
        float y[4];
#pragma unroll
        for (int r = 0; r < 4; ++r) y[r] = accP[vt][r] * rn * g4[r] * sigmoidf_(bf2f(o4[r]));
        u32x2 pk; pk[0] = pk_bf16(y[0], y[1]); pk[1] = pk_bf16(y[2], y[3]);
        *(u32x2*)(ymix + tm_off(rowt, h * 128 + v0, DM)) = pk;
    }
    __syncthreads();
}

template <int V> DI void swa_item(const Params& P, unsigned char* smem, int item) {
    const int tid = threadIdx.x, lane = tid & 63, wid = __builtin_amdgcn_readfirstlane(tid >> 6), fr = lane & 15, fq = lane >> 4;
    const int kvh = item & 1, nb = (item >> 1) & 31, b = item >> 6;
    const bf16_t* proj = (const bf16_t*)(P.ws + O_BIG);
    bf16_t* Kn = (bf16_t*)smem;
    bf16_t* Vt = Kn + 256 * 72;
    const long row0 = (long)b * 4096 + (long)(nb - 1) * 128;
    const int qi = 16 * wid + fr;
    const size_t qrow = (size_t)b * 4096 + nb * 128 + qi;
    bf16x8 Qn[2];
#pragma unroll
    for (int ks = 0; ks < 2; ++ks) Qn[ks] = *(const bf16x8*)(proj + pj(qrow, C_QA + (kvh * 4) * 64 + 32 * ks + 8 * fq));
    bf16x8 kraw[4], vraw[4];
#pragma unroll
    for (int i = 0; i < 4; ++i) {
        const int id = tid + 512 * i;
        { const int j = id >> 3, ch = id & 7; const bool valid = (V != 2) && ((nb > 0) || (j >= 128));
          kraw[i] = (bf16x8){0, 0, 0, 0, 0, 0, 0, 0};
          if (valid) kraw[i] = *(const bf16x8*)(proj + pj((size_t)(row0 + j), C_KA + kvh * 64 + ch * 8)); }
        { const int j = id & 255, ch = id >> 8; const bool valid = (V != 2) && ((nb > 0) || (j >= 128));
          vraw[i] = (bf16x8){0, 0, 0, 0, 0, 0, 0, 0};
          if (valid) vraw[i] = *(const bf16x8*)(proj + pj((size_t)(row0 + j), C_VA + kvh * 64 + ch * 8)); }
    }
#pragma unroll
    for (int i = 0; i < 4; ++i) {
        const int id = tid + 512 * i, j = id >> 3, ch = id & 7;
        const bf16x8 kv = kraw[i];
        float f[8]; float ss = 0.f;
#pragma unroll
        for (int e = 0; e < 8; ++e) { f[e] = bf2f(kv[e]); ss += f[e] * f[e]; }
        ss += __shfl_xor(ss, 1); ss += __shfl_xor(ss, 2); ss += __shfl_xor(ss, 4);
        const float rs = rsqrtf(ss * (1.f / 64.f) + EPS);
        const f32x4 g0 = *(const f32x4*)(P.gk + ch * 8), g1 = *(const f32x4*)(P.gk + ch * 8 + 4);
#pragma unroll
        for (int e = 0; e < 4; ++e) { f[e] *= rs * g0[e]; f[4 + e] *= rs * g1[e]; }
        *(bf16x8*)(Kn + j * 72 + ch * 8) = pack8(f);
        if (nb == 31 && j >= 128) {
            float* dst = P.out + OUT_PK + ((size_t)(b * 128 + (j - 128)) * 2 + kvh) * 64 + ch * 8;
            *(f32x4*)dst = (f32x4){f[0], f[1], f[2], f[3]}; *(f32x4*)(dst + 4) = (f32x4){f[4], f[5], f[6], f[7]};
        }
    }
#pragma unroll
    for (int i = 0; i < 4; ++i) {
        const int id = tid + 512 * i, j = id & 255, ch = id >> 8;
        const bf16x8 vv = vraw[i];
#pragma unroll
        for (int e = 0; e < 8; ++e) Vt[(ch * 8 + e) * 264 + j] = vv[e];
        if (nb == 31 && j >= 128) {
            float* dst = P.out + OUT_PV + ((size_t)(b * 128 + (j - 128)) * 2 + kvh) * 64 + ch * 8;
            *(f32x4*)dst = (f32x4){bf2f(vv[0]), bf2f(vv[1]), bf2f(vv[2]), bf2f(vv[3])}; *(f32x4*)(dst + 4) = (f32x4){bf2f(vv[4]), bf2f(vv[5]), bf2f(vv[6]), bf2f(vv[7])};
        }
    }
    __syncthreads();
    bf16_t* ymix = (bf16_t*)(P.ws + O_YMIX);
    const int st0 = 2 * (wid >> 1);
#pragma unroll 1
    for (int hh = 0; hh < 4; ++hh) {
        const int head = kvh * 4 + hh;
        bf16x8 Qc[2] = {Qn[0], Qn[1]};
        if (hh < 3) {
#pragma unroll
            for (int ks = 0; ks < 2; ++ks) Qn[ks] = *(const bf16x8*)(proj + pj(qrow, C_QA + (head + 1) * 64 + 32 * ks + 8 * fq));
        }
        bf16x8 Bq[2];
        { float f[16]; float ss = 0.f;
#pragma unroll
          for (int ks = 0; ks < 2; ++ks) { const bf16x8 q = Qc[ks];
#pragma unroll
              for (int e = 0; e < 8; ++e) { f[ks * 8 + e] = bf2f(q[e]); ss += f[ks * 8 + e] * f[ks * 8 + e]; } }
          ss += __shfl_xor(ss, 16); ss += __shfl_xor(ss, 32);
          const float rs = rsqrtf(ss * (1.f / 64.f) + EPS) * 0.125f;
#pragma unroll
          for (int ks = 0; ks < 2; ++ks) {
              const f32x4 g0 = *(const f32x4*)(P.gq + 32 * ks + 8 * fq), g1 = *(const f32x4*)(P.gq + 32 * ks + 8 * fq + 4);
#pragma unroll
              for (int e = 0; e < 4; ++e) { f[ks * 8 + e] *= rs * g0[e]; f[ks * 8 + 4 + e] *= rs * g1[e]; }
              Bq[ks] = pack8(f + ks * 8);
          } }
        f32x4 S[10];
#pragma unroll
        for (int i = 0; i < 10; ++i) {
            S[i] = (f32x4){0.f, 0.f, 0.f, 0.f};
#pragma unroll
            for (int ks = 0; ks < 2; ++ks) {
                const bf16x8 a = *(const bf16x8*)(Kn + (16 * (st0 + i) + fr) * 72 + 32 * ks + 8 * fq);
                S[i] = MFMA16(a, Bq[ks], S[i]);
            }
            if ((i & 3) == 3) asm volatile("" ::: "memory");
        }
        const float sink = P.sinks[head];
        float mx = sink;
#pragma unroll
        for (int i = 0; i < 10; ++i)
#pragma unroll
            for (int r = 0; r < 4; ++r) {
                const int j = 16 * (st0 + i) + 4 * fq + r;
                const bool ok = (j >= qi) && (j <= qi + 128) && ((nb > 0) || (j >= 128));
                S[i][r] = ok ? S[i][r] : -INFINITY;
                mx = fmaxf(mx, S[i][r]);
            }
        mx = fmaxf(mx, __shfl_xor(mx, 16)); mx = fmaxf(mx, __shfl_xor(mx, 32));
        float sum = 0.f;
#pragma unroll
        for (int i = 0; i < 10; ++i)
#pragma unroll
            for (int r = 0; r < 4; ++r) { const float pe = __expf(S[i][r] - mx); S[i][r] = pe; sum += pe; }
        sum += __shfl_xor(sum, 16); sum += __shfl_xor(sum, 32);
        const float invden = 1.f / (sum + __expf(sink - mx));
        f32x4 O[4];
#pragma unroll
        for (int dt = 0; dt < 4; ++dt) O[dt] = (f32x4){0.f, 0.f, 0.f, 0.f};
#pragma unroll
        for (int pp = 0; pp < 5; ++pp) {
            float pv[8];
#pragma unroll
            for (int r = 0; r < 4; ++r) { pv[r] = S[2 * pp][r]; pv[4 + r] = S[2 * pp + 1][r]; }
            const bf16x8 Bp = pack8(pv);
#pragma unroll
            for (int dt = 0; dt < 4; ++dt) {
                const bf16x4 lo = *(const bf16x4*)(Vt + (16 * dt + fr) * 264 + 16 * (st0 + 2 * pp) + 4 * fq);
                const bf16x4 hi = *(const bf16x4*)(Vt + (16 * dt + fr) * 264 + 16 * (st0 + 2 * pp) + 16 + 4 * fq);
                const bf16x8 a = {lo[0], lo[1], lo[2], lo[3], hi[0], hi[1], hi[2], hi[3]};
                O[dt] = MFMA16(a, Bp, O[dt]);
            }
            asm volatile("" ::: "memory");
        }
#pragma unroll
        for (int dt = 0; dt < 4; ++dt) {
            u32x2 pk; pk[0] = pk_bf16(O[dt][0] * invden, O[dt][1] * invden); pk[1] = pk_bf16(O[dt][2] * invden, O[dt][3] * invden);
            *(u32x2*)(ymix + tm_off(qrow, 512 + head * 64 + 16 * dt + 4 * fq, DM)) = pk;
        }
    }
    __syncthreads();
}

DI void smlstm_item(const Params& P, unsigned char* smem, int item) {
    const int tid = threadIdx.x, lane = tid & 63, wid = tid >> 6;
    const int h = item & 3, b = item >> 2;
    const size_t r = (size_t)TP + b;
    const bf16_t* proj = (const bf16_t*)(P.ws + O_BIG);
    const float* gates = (const float*)(P.ws + O_GATE);
    float* lq = (float*)smem; float* lk = lq + 128; float* lv = lk + 128; float* lcq = lv + 128; float* red = lcq + 128;
    const int sub = tid & 31, vr = tid >> 5;
    const float* __restrict__ Cin = P.sC + (size_t)item * 16384; float* __restrict__ Cout = P.out + OUT_SC + (size_t)item * 16384;
    f32x4 creg[8];
#pragma unroll
    for (int it = 0; it < 8; ++it) creg[it] = __builtin_nontemporal_load((const f32x4*)(Cin + (vr + 16 * it) * 128 + 4 * sub));
    float q = 0.f, k = 0.f, v = 0.f, n0 = 0.f;
    if (tid < 128) {
        q = bf2f(proj[pj(r, C_QM + h * 128 + tid)]); k = bf2f(proj[pj(r, C_KM + h * 128 + tid)]) * KSCALE; v = bf2f(proj[pj(r, C_VM + h * 128 + tid)]);
        n0 = P.sn[(size_t)item * 128 + tid];
        lq[tid] = q; lk[tid] = k; lv[tid] = v;
    }
    float qk = q * k, nq = n0 * q;
#pragma unroll
    for (int o = 32; o >= 1; o >>= 1) { qk += __shfl_xor(qk, o); nq += __shfl_xor(nq, o); }
    if (lane == 0 && wid < 2) { red[wid] = qk; red[2 + wid] = nq; }
    __syncthreads();
    qk = red[0] + red[1]; nq = red[2] + red[3];
    const float ip = gates[r * 8 + h], lf = gates[r * 8 + 4 + h], m0 = P.sm[item];
    const float mnew = fmaxf(lf + m0, ip), decay = __expf(lf + m0 - mnew), wend = __expf(ip - mnew);
    const float score = qk * wend;
    {
        const f32x4 q4 = *(const f32x4*)(lq + 4 * sub), k4 = *(const f32x4*)(lk + 4 * sub);
#pragma unroll
        for (int it = 0; it < 8; ++it) {
            const int vv = vr + 16 * it;
            const f32x4 cc = creg[it];
            float part = cc[0] * q4[0] + cc[1] * q4[1] + cc[2] * q4[2] + cc[3] * q4[3];
            const float wv = wend * lv[vv];
            __builtin_nontemporal_store(decay * cc + wv * k4, (f32x4*)(Cout + vv * 128 + 4 * sub));
#pragma unroll
            for (int o = 16; o >= 1; o >>= 1) part += __shfl_xor(part, o);
            if (sub == 0) lcq[vv] = part;
        }
    }
    __syncthreads();
    float hv = 0.f;
    if (tid < 128) {
        const float num = decay * lcq[tid] + score * v, den = decay * nq + score;
        hv = num / fmaxf(fabsf(den), __expf(-mnew));
        P.out[OUT_SN + (size_t)item * 128 + tid] = decay * n0 + wend * k;
        if (tid == 0) P.out[OUT_SM + item] = mnew;
    }
    float ssq = hv * hv;
#pragma unroll
    for (int o = 32; o >= 1; o >>= 1) ssq += __shfl_xor(ssq, o);
    if (lane == 0 && wid < 2) red[4 + wid] = ssq;
    __syncthreads();
    if (tid < 128) {
        const float rn = rsqrtf((red[4] + red[5]) * (1.f / 128.f) + EPS);
        const float o = bf2f(proj[pj(r, C_OM + h * 128 + tid)]);
        ((bf16_t*)(P.ws + O_YMIX))[tm_off(r, h * 128 + tid, DM)] = (bf16_t)f2bf(hv * rn * P.gout[h * 128 + tid] * sigmoidf_(o));
    }
    __syncthreads();
}

DI void sswa_item(const Params& P, unsigned char* smem, int item) {
    const int tid = threadIdx.x, lane = tid & 63, wid = tid >> 6;
    const int kvh = item & 1, b = item >> 1;
    const size_t r = (size_t)TP + b;
    const bf16_t* proj = (const bf16_t*)(P.ws + O_BIG);
    float* Kc = (float*)smem;
    float* Vc = Kc + 129 * 64;
    float* lq = Vc + 129 * 64;
    float* lp = lq + 256;
    const float* ckb = P.ck + (size_t)b * 16384 + kvh * 64; const float* cvb = P.cv + (size_t)b * 16384 + kvh * 64;
#pragma unroll
    for (int i = 0; i < 4; ++i) {
        const int id = tid + 512 * i, j = id >> 4, q4 = (id & 15) * 4;
        *(f32x4*)(Kc + j * 64 + q4) = __builtin_nontemporal_load((const f32x4*)(ckb + j * 128 + q4));
        *(f32x4*)(Vc + j * 64 + q4) = __builtin_nontemporal_load((const f32x4*)(cvb + j * 128 + q4));
    }
    if (tid < 256) {
        const float qraw = bf2f(proj[pj(r, C_QA + kvh * 256 + tid)]);
        float ss = qraw * qraw;
#pragma unroll
        for (int o = 32; o >= 1; o >>= 1) ss += __shfl_xor(ss, o);
        lq[tid] = qraw * rsqrtf(ss * (1.f / 64.f) + EPS) * P.gq[lane] * 0.125f;
    } else if (tid < 320) {
        const float kraw = bf2f(proj[pj(r, C_KA + kvh * 64 + lane)]);
        float s2 = kraw * kraw;
#pragma unroll
        for (int o = 32; o >= 1; o >>= 1) s2 += __shfl_xor(s2, o);
        Kc[128 * 64 + lane] = kraw * rsqrtf(s2 * (1.f / 64.f) + EPS) * P.gk[lane];
        Vc[128 * 64 + lane] = bf2f(proj[pj(r, C_VA + kvh * 64 + lane)]);
    }
    __syncthreads();
    {
        float* okb = P.out + OUT_SK + (size_t)b * 16384 + kvh * 64; float* ovb = P.out + OUT_SV + (size_t)b * 16384 + kvh * 64;
#pragma unroll
        for (int i = 0; i < 4; ++i) {
            const int id = tid + 512 * i, j = id >> 4, q4 = (id & 15) * 4;
            __builtin_nontemporal_store(*(const f32x4*)(Kc + (j + 1) * 64 + q4), (f32x4*)(okb + j * 128 + q4));
            __builtin_nontemporal_store(*(const f32x4*)(Vc + (j + 1) * 64 + q4), (f32x4*)(ovb + j * 128 + q4));
        }
    }
    for (int idx = tid; idx < 4 * 129; idx += 512) {
        const int head = idx / 129, j = idx - head * 129;
        float s = 0.f;
#pragma unroll 8
        for (int d = 0; d < 64; ++d) { const int dd = (d + lane) & 63; s += Kc[j * 64 + dd] * lq[head * 64 + dd]; }
        lp[head * 132 + j] = s;
    }
    __syncthreads();
    if (wid < 4) {
        const int head = wid; const float sink = P.sinks[kvh * 4 + head];
        const float s0 = lp[head * 132 + lane], s1 = lp[head * 132 + 64 + lane], s2 = (lane == 0) ? lp[head * 132 + 128] : -INFINITY;
        float mx = fmaxf(fmaxf(s0, s1), fmaxf(s2, sink));
#pragma unroll
        for (int o = 32; o >= 1; o >>= 1) mx = fmaxf(mx, __shfl_xor(mx, o));
        const float p0 = __expf(s0 - mx), p1 = __expf(s1 - mx), p2 = (lane == 0) ? __expf(s2 - mx) : 0.f;
        float sum = p0 + p1 + p2;
#pragma unroll
        for (int o = 32; o >= 1; o >>= 1) sum += __shfl_xor(sum, o);
        const float inv = 1.f / (sum + __expf(sink - mx));
        lp[head * 132 + lane] = p0 * inv; lp[head * 132 + 64 + lane] = p1 * inv; if (lane == 0) lp[head * 132 + 128] = p2 * inv;
    }
    __syncthreads();
    if (wid < 4) {
        const int head = wid; float o = 0.f;
#pragma unroll 4
        for (int j = 0; j < 129; ++j) o += lp[head * 132 + j] * Vc[j * 64 + lane];
        ((bf16_t*)(P.ws + O_YMIX))[tm_off(r, 512 + (kvh * 4 + head) * 64 + lane, DM)] = (bf16_t)f2bf(o);
    }
    __syncthreads();
}

constexpr int NPHASE = 10;
#ifndef PHMASK
#define PHMASK 0x3ff
#endif
#define PHEN(p) ((PHMASK >> (p)) & 1)
#ifndef ITMASK
#define ITMASK 0xf
#endif
#define ITEN(p) ((ITMASK >> (p)) & 1)
#ifndef RPTITMASK
#define RPTITMASK 0xf
#endif
#define RPTIT(p) ((RPTITMASK >> (p)) & 1)
#ifndef RPTVAR
#define RPTVAR 0
#endif
template <bool LAST> DI void sample_strip_gemm(const Params& P, unsigned char* smem, const bf16_t* A, const bf16_t* Bt, int K, float scale) {
    const int lane = threadIdx.x & 63, wid = threadIdx.x >> 6, fr = lane & 15, fq = lane >> 4;
    const int rt = wid & 1, kq = wid >> 1;
    f32x4* red = (f32x4*)smem;
    const int nks = K / 128;
    for (int u = blockIdx.x; u < 256; u += gridDim.x) {
        const int cgp = u & 63, rg = u >> 6;
        const size_t rbase = (size_t)TP + 32 * rg + 16 * rt;
        const bf16_t* ap = A + tm_off(rbase + fr, 0, K) + 8 * fq;
        const bf16_t* bp = Bt + tm_off((size_t)16 * cgp + fr, 0, K) + 8 * fq;
        f32x4 acc0 = {0.f, 0.f, 0.f, 0.f}, acc1 = {0.f, 0.f, 0.f, 0.f};
#pragma unroll 6
        for (int ks = kq * nks; ks < (kq + 1) * nks; ks += 2) {
            const size_t o = (size_t)(ks >> 1) * 16384;
            const bf16x8 a0 = *(const bf16x8*)(ap + o), b0 = *(const bf16x8*)(bp + o);
            const bf16x8 a1 = *(const bf16x8*)(ap + o + 32), b1 = *(const bf16x8*)(bp + o + 32);
            acc0 = MFMA16(a0, b0, acc0); acc1 = MFMA16(a1, b1, acc1);
        }
        red[wid * 64 + lane] = acc0 + acc1;
        __syncthreads();
        if (wid < 2) {
            const f32x4 t = red[(0 + rt) * 64 + lane] + red[(2 + rt) * 64 + lane] + red[(4 + rt) * 64 + lane] + red[(6 + rt) * 64 + lane];
            bf16_t* xb = (bf16_t*)(P.ws + O_XB);
#pragma unroll
            for (int r = 0; r < 4; ++r) {
                const size_t row = rbase + 4 * fq + r; const int col = 16 * cgp + fr;
                float* op = P.out + row * DM + col;
                const float v = *op + scale * t[r];
                *op = v;
                if (!LAST) xb[tm_off(row, col, DM)] = (bf16_t)f2bf(v);
            }
        }
        __syncthreads();
    }
}

#define XB_TMO      128
#define XB_XCNT(j)  (256  + 64 * (j))
#define XB_XSUB(j)  (1280 + 64 * (j))
#define XB_XGEN(j)  (2304 + 64 * (j))
#define XB_TOP      3328
#define XB_TOPGEN   3392
#define XCD_BAR_WORDS 3456
#define XB_SPIN_CAP (1u << 18)
DI unsigned xb_ld(unsigned* p)              { return __hip_atomic_load(p, __ATOMIC_RELAXED, __HIP_MEMORY_SCOPE_AGENT); }
DI unsigned xb_add(unsigned* p, unsigned v) { return __hip_atomic_fetch_add(p, v, __ATOMIC_RELAXED, __HIP_MEMORY_SCOPE_AGENT); }
DI unsigned xb_xcc_id() { return (unsigned)__builtin_amdgcn_s_getreg((3 << 11) | 20) & 0xFu; }
#define XB_SPIN(cond, bar) do { unsigned _sp = 0; while (cond) { __builtin_amdgcn_s_sleep(1); \
    if ((++_sp & 255u) == 0u) { if (xb_ld(&(bar)[XB_TMO])) break; if (_sp > XB_SPIN_CAP) { atomicAdd(&(bar)[XB_TMO], 1u); break; } } } } while (0)
struct XcdBarrier { unsigned* bar; unsigned x; volatile LAS unsigned* st; };
DI XcdBarrier xcd_barrier_post(unsigned* bar, volatile LAS unsigned* st) {
    XcdBarrier b; b.bar = bar; b.x = xb_xcc_id(); b.st = st;
    if (threadIdx.x == 0) (void)xb_add(&bar[XB_XCNT(b.x)], 1u);
    return b;
}
DI void xcd_barrier_complete(unsigned* bar, unsigned x, unsigned& nloc, unsigned& nx) {
    const unsigned G = gridDim.x * gridDim.y * gridDim.z;
    unsigned sum, cnt, mine, sp = 0u;
    for (;;) {
        sum = 0u; cnt = 0u; mine = 0u;
#pragma unroll
        for (unsigned j = 0; j < 16; ++j) { const unsigned c = xb_ld(&bar[XB_XCNT(j)]); sum += c; cnt += (c > 0u) ? 1u : 0u; mine = (j == x) ? c : mine; }
        if (sum == G) break;
        __builtin_amdgcn_s_sleep(1);
        if ((++sp & 255u) == 0u) { if (xb_ld(&bar[XB_TMO])) break; if (sp > XB_SPIN_CAP) { atomicAdd(&bar[XB_TMO], 1u); break; } }
    }
    nloc = mine > 0u ? mine : 1u; nx = cnt > 0u ? cnt : 1u;
}
DI void xcd_barrier(const XcdBarrier& b) {
    asm volatile("s_waitcnt vmcnt(0)" ::: "memory");
    __syncthreads();
    if (threadIdx.x == 0) {
        unsigned* bar = b.bar;
        __builtin_amdgcn_s_waitcnt(0);
        unsigned nloc = b.st[0], nx = b.st[1];
        if (nloc == 0u) { xcd_barrier_complete(bar, b.x, nloc, nx); b.st[0] = nloc; b.st[1] = nx; }
        const unsigned old = xb_add(&bar[XB_XSUB(b.x)], 1u);
        const unsigned gen = old / nloc;
        if (old + 1u == (gen + 1u) * nloc) {
            __builtin_amdgcn_fence(__ATOMIC_RELEASE, "agent");
            asm volatile("s_waitcnt vmcnt(0)" ::: "memory");
            const unsigned og = xb_add(&bar[XB_TOP], 1u);
            const unsigned tg = og / nx;
            if (og + 1u == (tg + 1u) * nx) xb_add(&bar[XB_TOPGEN], 1u);
            else XB_SPIN(xb_ld(&bar[XB_TOPGEN]) == tg, bar);
            __builtin_amdgcn_fence(__ATOMIC_ACQUIRE, "agent");
            xb_add(&bar[XB_XGEN(b.x)], 1u);
            asm volatile("s_waitcnt vmcnt(0)" ::: "memory");
        } else {
            XB_SPIN(xb_ld(&bar[XB_XGEN(b.x)]) == gen, bar);
            __builtin_amdgcn_fence(__ATOMIC_ACQUIRE, "agent");
            asm volatile("s_waitcnt vmcnt(0)" ::: "memory");
        }
    }
    __syncthreads();
}

constexpr size_t O_PRIV = WS_TOTAL;
constexpr size_t WS_TOTAL2 = O_PRIV + (size_t)256 * 256 * DM * 2 / 8;
constexpr size_t O_BAR = WS_TOTAL2;
constexpr size_t WS_TOTAL3 = O_BAR + AL(XCD_BAR_WORDS * 4);
static_assert(WS_TOTAL3 <= (size_t)256 * 1024 * 1024, "workspace too large");
template <int K, bool RPT = false> DI void run_phase(const Params& P, unsigned char* smem) {
    LAS unsigned char* lds = (LAS unsigned char*)smem;
    pg8::MixOrder S;
    const int G = gridDim.x, c = blockIdx.x;
    bf16_t* xb = (bf16_t*)(P.ws + O_XB); bf16_t* big = (bf16_t*)(P.ws + O_BIG); float* ssq = (float*)(P.ws + O_SSQ);
    if constexpr (K == 0) phase0(P, smem);
    if constexpr (K == 1) {
        pg8::Gemm g{xb, xb + (size_t)TP * DM, (const bf16_t*)(P.ws + O_WGU1), DM};
        S.init(2 * FF, DM, G, c, G - 22 > 0 ? G - 22 : 0, 22, 1, 0);
        prep_rstd(smem, ssq, 1, S, nullptr);
        EpiSwiGLU E{big, (const LAS float*)(lds + RSL_OFF)};
        pg8::gemm_phase(lds, g, S, E);
        if (!RPT && G == 256 && c >= 128 && c < 234) {
            for (int j = c - 128; j < 704; j += 106) convert_weight_unit(P, (float*)smem, j < 352 ? 352 + j : 768 + (j - 352));
        }
    }
    if constexpr (K == 8) {
        pg8::Gemm g{xb, xb + (size_t)TP * DM, (const bf16_t*)(P.ws + O_WGU2), DM};
        S.init(2 * FF, DM, G, c, G - 22 > 0 ? G - 22 : 0, 22, 1, 0);
        prep_rstd(smem, ssq, 16, S, xb);
        EpiSwiGLU E{big, (const LAS float*)(lds + RSL_OFF)};
        pg8::gemm_phase(lds, g, S, E);
    }
    if constexpr (K == 2) {
        if (!RPT) sample_strip_gemm<false>(P, smem, big, (const bf16_t*)(P.ws + O_WD1), FF, 0.5f);
        pg8::Gemm g{big, big + (size_t)TP * FF, (const bf16_t*)(P.ws + O_WD1), FF};
        S.init(DM, FF, G, c, 0, 0, 2, 4);
        EpiResid<false> E{P.out, RPT ? 0.f : 0.5f, xb, ssq};
        pg8::gemm_phase(lds, g, S, E);
    }
    if constexpr (K == 3) {
        pg8::Gemm g{xb, xb + (size_t)TP * DM, (const bf16_t*)(P.ws + O_WIN), DM};
        S.init(PW, DM, G, c, G - 11 > 0 ? G - 11 : 0, 11, 1, 0);
        prep_rstd(smem, ssq, 16, S, xb);
        EpiRowScale E{big, PW, (const LAS float*)(lds + RSL_OFF)};
        pg8::gemm_phase(lds, g, S, E);
        if (!RPT && G == 256 && c >= 192 && c < 245) {
            for (int j = c - 192; j < 240; j += 53) convert_weight_unit(P, (float*)smem, j < 64 ? 704 + j : 1120 + (j - 64));
        }
        gates_pass(P, smem);
    }
    if constexpr (K == 4) {
        const int nk = (1536 + (int)gridDim.x - 1) / (int)gridDim.x, rot = ((int)blockIdx.x % 3) * 2;
        for (int kk = 0; kk < nk; ++kk) {
            const int k = (kk + rot) % nk; const int it = blockIdx.x + k * gridDim.x;
            if (it >= 1536) continue;
            Params Q = P;
            asm volatile("" : "+s"(Q.ws), "+s"(Q.out));
            if (it < 512) { if (!RPT) m1_item<0>(Q, smem, it); else if (RPTIT(0)) m1_item<RPTVAR>(Q, smem, it); }
            else if (it < 768) { if (!RPT) swa_item<0>(Q, smem, it - 512); else if (RPTIT(1)) swa_item<RPTVAR>(Q, smem, it - 512); }
            else if (it < 1280) { if (!RPT || RPTIT(2)) smlstm_item(Q, smem, it - 768); }
            else { if (!RPT || RPTIT(3)) sswa_item(Q, smem, it - 1280); }
        }
    }
    if constexpr (K == 5) scan_phase(P, smem);
    if constexpr (K == 6) { for (int it = blockIdx.x; it < 512; it += gridDim.x) { if (!RPT) m3_item<0>(P, smem, it); else m3_item<RPTVAR>(P, smem, it); } }
    if constexpr (K == 7) {
        bf16_t* ym = (bf16_t*)(P.ws + O_YMIX);
        if (!RPT) sample_strip_gemm<false>(P, smem, ym, (const bf16_t*)(P.ws + O_WOUT), DM, 1.0f);
        pg8::Gemm g{ym, ym + (size_t)TP * DM, (const bf16_t*)(P.ws + O_WOUT), DM};
        S.init(DM, DM, G, c, 0, 0, 2, 4);
        EpiResid<false> E{P.out, RPT ? 0.f : 1.0f, xb, ssq};
        pg8::gemm_phase(lds, g, S, E);
    }
    if constexpr (K == 9) {
        if (!RPT) sample_strip_gemm<true>(P, smem, big, (const bf16_t*)(P.ws + O_WD2), FF, 0.5f);
        pg8::Gemm g{big, big + (size_t)TP * FF, (const bf16_t*)(P.ws + O_WD2), FF};
        S.init(DM, FF, G, c, 0, 0, 2, 4);
        EpiResid<true> E{P.out, RPT ? 0.f : 0.5f, xb, nullptr};
        pg8::gemm_phase(lds, g, S, E);
    }
}
#ifndef REPMASK
#define REPMASK 0
#endif
#define REP(k) ((REPMASK >> (k)) & 1)
__global__ void __launch_bounds__(512) hymba_megakernel(Params P, int ph_lo, int ph_hi) {
    extern __shared__ __attribute__((aligned(16))) unsigned char smem[];
    cg::grid_group grid = cg::this_grid();
    if (ph_lo < 0) grid.sync();
    volatile LAS unsigned* st = (volatile LAS unsigned*)((LAS unsigned char*)smem + (LDS_BYTES - 16));
    if (threadIdx.x == 0) { st[0] = 0u; st[1] = 0u; }
    __syncthreads();
    const XcdBarrier xb = xcd_barrier_post((unsigned*)(P.ws + O_BAR), st);
#define GSYNC() xcd_barrier(xb)
#define DOPH(k) do { if (PHEN(k) && ph_lo <= (k) && (k) < ph_hi) { if (REP(k)) { run_phase<k, true>(P, smem); GSYNC(); } run_phase<k>(P, smem); } \
                     if (ph_lo <= (k) && (k) + 1 < ph_hi) GSYNC(); } while (0)
#ifdef EXTRA_SYNC
    for (int i = 0; i < EXTRA_SYNC; ++i) GSYNC();
#endif
    DOPH(0); DOPH(1); DOPH(2); DOPH(3); DOPH(4); DOPH(5); DOPH(6); DOPH(7); DOPH(8); DOPH(9);
}

#ifndef MK_MULTI
#define MK_MULTI 0
#endif

extern "C" void kernel_launch(void* const* d_in, const int* in_sizes, int n_in, void* d_out, int out_size, void* d_ws, size_t ws_size, hipStream_t stream) {
    (void)in_sizes; (void)n_in; (void)out_size;
    static int grid_blocks = 0;
    if (!grid_blocks) {
        int dev = 0, cus = 0, per_cu = 0;
        hipGetDevice(&dev);
        hipDeviceGetAttribute(&cus, hipDeviceAttributeMultiprocessorCount, dev);
        hipFuncSetAttribute((const void*)hymba_megakernel, hipFuncAttributeMaxDynamicSharedMemorySize, LDS_BYTES);
        hipOccupancyMaxActiveBlocksPerMultiprocessor(&per_cu, hymba_megakernel, 512, LDS_BYTES);
        if (per_cu < 1) per_cu = 1;
        if (per_cu > 1) per_cu = 1;
        grid_blocks = cus * per_cu;
    }
    if (ws_size < WS_TOTAL3) { fprintf(stderr, "workspace too small: %zu < %zu\n", ws_size, (size_t)WS_TOTAL3); return; }
    Params p{};
    const float* const* in = (const float* const*)d_in;
    p.xp = in[0]; p.xs = in[1]; p.ck = in[2]; p.cv = in[3]; p.sC = in[4]; p.sn = in[5]; p.sm = in[6];
    p.g1 = in[7]; p.wg1 = in[8]; p.wu1 = in[9]; p.wd1 = in[10]; p.gmix = in[11]; p.win = in[12]; p.bi = in[13]; p.bfg = in[14];
    p.gout = in[15]; p.gq = in[16]; p.gk = in[17]; p.sinks = in[18]; p.wout = in[19]; p.g2 = in[20]; p.wg2 = in[21]; p.wu2 = in[22]; p.wd2 = in[23];
    p.out = (float*)d_out; p.ws = (unsigned char*)d_ws;
#if MK_MULTI
    for (int ph = 0; ph < NPHASE; ++ph) hipLaunchKernelGGL(hymba_megakernel, dim3(grid_blocks), dim3(512), LDS_BYTES, stream, p, ph, ph + 1);
#else
    hipMemsetAsync((unsigned char*)d_ws + O_BAR, 0, XCD_BAR_WORDS * 4, stream);
    int lo = 0, hi = NPHASE;
    void* args[] = {&p, &lo, &hi};
    hipError_t e = hipLaunchCooperativeKernel((const void*)hymba_megakernel, dim3(grid_blocks), dim3(512), args, LDS_BYTES, stream);
    if (e != hipSuccess) fprintf(stderr, "cooperative launch failed: %s (grid %d)\n", hipGetErrorString(e), grid_blocks);
#endif
}
```

```cpp
#include <hip/hip_runtime.h>
#include <hip/hip_cooperative_groups.h>
#include <cstdio>
namespace cg = cooperative_groups;

#define LAS __attribute__((address_space(3)))
typedef unsigned short bf16_t;
typedef short bf16x8 __attribute__((ext_vector_type(8)));
typedef short bf16x4 __attribute__((ext_vector_type(4)));
typedef float f32x4 __attribute__((ext_vector_type(4)));
typedef float f32x2 __attribute__((ext_vector_type(2)));
typedef __bf16 bfv2 __attribute__((ext_vector_type(2)));
typedef unsigned u32x4 __attribute__((ext_vector_type(4)));
typedef unsigned u32x2 __attribute__((ext_vector_type(2)));

#define DI __device__ __forceinline__

constexpr int TP = 16384, TS = 128, MV = TP + TS, MP = 16640;
constexpr int DM = 1024, FF = 2816, PW = 2816, WIN_LD = 2824;
constexpr float KSCALE = 0.08838834764831845f;
constexpr float EPS = 1e-6f;
constexpr int LDS_BYTES = 147456;

constexpr size_t AL(size_t x) { return (x + 255) & ~(size_t)255; }
constexpr size_t O_WGU1 = 0;
constexpr size_t O_WD1  = O_WGU1 + AL((size_t)2 * FF * DM * 2);
constexpr size_t O_WIN  = O_WD1 + AL((size_t)DM * FF * 2);
constexpr size_t O_WOUT = O_WIN + AL((size_t)PW * DM * 2);
constexpr size_t O_WGU2 = O_WOUT + AL((size_t)DM * DM * 2);
constexpr size_t O_WD2  = O_WGU2 + AL((size_t)2 * FF * DM * 2);
constexpr size_t O_XB   = O_WD2 + AL((size_t)DM * FF * 2);
constexpr size_t O_BIG  = O_XB + AL((size_t)MP * DM * 2);
constexpr size_t O_YMIX = O_BIG + AL((size_t)MP * FF * 2);
constexpr size_t O_CST  = O_YMIX + AL((size_t)MP * DM * 2);
constexpr size_t O_SSQ  = O_CST + AL((size_t)512 * 16384 * 2);
constexpr size_t O_GATE = O_SSQ + AL((size_t)16 * MP * 4);
constexpr size_t O_DN   = O_GATE + AL((size_t)MP * 8 * 4);
constexpr size_t O_NST  = O_DN + AL((size_t)512 * 128 * 4);
constexpr size_t O_ML   = O_NST + AL((size_t)512 * 128 * 4);
constexpr size_t O_BL   = O_ML + AL(512 * 4);
constexpr size_t O_MST  = O_BL + AL(512 * 4);
constexpr size_t WS_TOTAL = O_MST + AL(512 * 4);
static_assert(WS_TOTAL <= (size_t)256 * 1024 * 1024, "workspace too large");
static_assert((size_t)512 * 16384 * 4 <= (size_t)MP * DM * 2, "dC alias");

constexpr size_t OUT_Y = 0;
constexpr size_t OUT_PK = (size_t)MV * DM;
constexpr size_t OUT_PV = OUT_PK + 65536;
constexpr size_t OUT_PC = OUT_PV + 65536;
constexpr size_t OUT_PN = OUT_PC + 262144;
constexpr size_t OUT_PM = OUT_PN + 2048;
constexpr size_t OUT_SK = OUT_PM + 16;
constexpr size_t OUT_SV = OUT_SK + 2097152;
constexpr size_t OUT_SC = OUT_SV + 2097152;
constexpr size_t OUT_SN = OUT_SC + 8388608;
constexpr size_t OUT_SM = OUT_SN + 65536;

struct Params {
    const float *xp, *xs, *ck, *cv, *sC, *sn, *sm;
    const float *g1, *wg1, *wu1, *wd1, *gmix, *win, *bi, *bfg, *gout, *gq, *gk, *sinks, *wout, *g2, *wg2, *wu2, *wd2;
    float* out;
    unsigned char* ws;
};

DI size_t tm_off(size_t row, int col, int K) { return ((row >> 8) * (size_t)(K >> 6) + (size_t)(col >> 6)) * 16384 + (row & 255) * 64 + (col & 63); }
DI size_t pj(size_t row, int col);
DI unsigned pk_bf16(float a, float b) { f32x2 v = {a, b}; bfv2 r = __builtin_convertvector(v, bfv2); return __builtin_bit_cast(unsigned, r); }
DI float bf2f(short b) { return __uint_as_float(((unsigned)(unsigned short)b) << 16); }
DI short f2bf(float a) { return (short)(pk_bf16(a, 0.f) & 0xffffu); }
DI bf16x8 pack8(const float* f) { u32x4 p; p[0] = pk_bf16(f[0], f[1]); p[1] = pk_bf16(f[2], f[3]); p[2] = pk_bf16(f[4], f[5]); p[3] = pk_bf16(f[6], f[7]); return __builtin_bit_cast(bf16x8, p); }
DI float sigmoidf_(float x) { return 1.f / (1.f + __expf(-x)); }
#define MFMA16(a, b, c) __builtin_amdgcn_mfma_f32_16x16x32_bf16((a), (b), (c), 0, 0, 0)

namespace pg8 {
constexpr int BM = 256, BK = 64, HALF = 128, HTB = HALF * BK * 2, STAGE_BYTES = 8 * HTB, NXCD = 8, WGM = 8;
DI int lds_byte(int r, int c) { const int st = (r >> 4) * 2 + (c >> 5), rr = r & 15, cc = c & 31, ob = rr * 64 + cc * 2; return st * 1024 + (ob ^ (((ob >> 9) & 1) << 5)); }
DI void stage_rc(int b, int& R, int& C) { const int st = b / 1024, sb = b % 1024, swz = sb ^ (((sb >> 9) & 1) << 5); R = (st >> 1) * 16 + swz / 64; C = (st & 1) * 32 + (swz % 64) / 2; }
DI int perm32(int rho) { const int n = rho >> 4, i = rho & 15; return 8 * (i >> 2) + 4 * n + (i & 3); }
struct Unit { int pm, pn, ui, kt0, nt, kind; };
struct Gemm { const bf16_t* A; const bf16_t* A2; const bf16_t* Bt; int K; };
struct MixOrder {
    int nN, nwg, G, c, ntFull, sLo, sCnt, sKind, sNt;
    DI void init(int N, int K, int G_, int c_, int sLo_, int sCnt_, int sKind_, int sNt_) { nN = N / BM; nwg = 64 * nN; G = G_; c = c_; ntFull = K / BK; sLo = sLo_; sCnt = sCnt_; sKind = sKind_; sNt = sNt_; }
    DI bool next(int i, Unit& u) const {
        const bool hasS = (c >= sLo) && (c < sLo + sCnt);
        const bool isS = hasS && (i == 0);
        const int ii = hasS ? i - 1 : i;
        const long L = (long)ii * G + c;
        if (!isS && L >= nwg) return false;
        int wgid = isS ? 0 : (int)L; { const int q = nwg / NXCD, r = nwg % NXCD, xcd = wgid % NXCD, off = wgid / NXCD; wgid = (xcd < r ? xcd * (q + 1) : r * (q + 1) + (xcd - r) * q) + off; }
        const int nig = WGM * nN, gid = wgid / nig, fm = gid * WGM;
        const int ppm = fm + ((wgid % nig) % WGM), ppn = (wgid % nig) / WGM;
        const int idx = c - sLo;
        const int spn = (sKind == 1) ? idx : idx % nN, skt0 = (sKind == 1) ? 0 : (idx / nN) * sNt, snt = (sKind == 1) ? ntFull : sNt;
        Unit r;
        r.pm = isS ? 64 : ppm; r.pn = isS ? spn : ppn; r.ui = i; r.kt0 = isS ? skt0 : 0; r.nt = isS ? snt : ntFull; r.kind = isS ? sKind : 0;
        u = r;
        return true;
    }
    DI void a_ready(const Unit&) const {}
    DI void done(const Unit&) const {}
};

template <class Epi, class Sched>
DI void gemm_phase(LAS unsigned char* lds, const Gemm g, const Sched& S, const Epi& E) {
    const int tid = threadIdx.x, wid = __builtin_amdgcn_readfirstlane(tid >> 6), lane = tid & 63, wr = wid >> 2, wc = wid & 3, fr = lane & 15, fq = lane >> 4;
    const int K = g.K;
    unsigned voffA[2], voffB[2];
#pragma unroll
    for (int i = 0; i < 2; ++i) { int R, C; stage_rc(tid * 16 + i * 8192, R, C); const int Rb = Epi::PERM ? ((R & ~31) + perm32(R & 31)) : R;
        voffA[i] = (unsigned)(R * 64 + C) * 2u; voffB[i] = (unsigned)(Rb * 64 + C) * 2u; }
    const size_t kstep = (size_t)32768;
    const size_t hstep = (size_t)16384;
    const size_t tstep = (size_t)(K / BK) * kstep;
    const unsigned ldsw = (unsigned)wid * 1024u;
    const int aoff = lds_byte(wr * 64 + fr, fq * 8), boff = lds_byte(wc * 32 + fr, fq * 8);
#define PG8_SA(b, h) (((b) * 2 + (h)) * HTB)
#define PG8_SB(b, h) ((4 + (b) * 2 + (h)) * HTB)
#define PG8_STAGE(bufoff, gbase, voff) do { _Pragma("unroll") for (int _i = 0; _i < 2; ++_i) \
        __builtin_amdgcn_global_load_lds((const unsigned*)((const char*)(gbase) + (voff)[_i]), (LAS unsigned*)(lds + (bufoff) + ldsw + _i * 8192), 16, 0, 0); } while (0)
#define PG8_LDA(dst, b, h) do { _Pragma("unroll") for (int m = 0; m < 4; ++m) _Pragma("unroll") for (int k = 0; k < 2; ++k) dst[m][k] = *(const LAS bf16x8*)(lds + PG8_SA(b, h) + aoff + m * 2048 + k * 1024); } while (0)
#define PG8_LDB(dst, b, h) do { _Pragma("unroll") for (int n = 0; n < 2; ++n) _Pragma("unroll") for (int k = 0; k < 2; ++k) dst[n][k] = *(const LAS bf16x8*)(lds + PG8_SB(b, h) + boff + n * 2048 + k * 1024); } while (0)
#define PG8_MMA(ai, bj, At, Bt) do { __builtin_amdgcn_s_setprio(1); _Pragma("unroll") for (int m = 0; m < 4; ++m) _Pragma("unroll") for (int n = 0; n < 2; ++n) _Pragma("unroll") for (int k = 0; k < 2; ++k) \
        acc[ai][bj][m][n] = __builtin_amdgcn_mfma_f32_16x16x32_bf16(Bt[n][k], At[m][k], acc[ai][bj][m][n], 0, 0, 0); __builtin_amdgcn_s_setprio(0); } while (0)
#define PG8_WAIT_V(n) asm volatile("s_waitcnt vmcnt(" #n ")" ::: "memory")
#define PG8_WAIT_L(n) asm volatile("s_waitcnt lgkmcnt(" #n ")" ::: "memory")
#define PG8_BAR __builtin_amdgcn_s_barrier()
#define PG8_SCHED __builtin_amdgcn_sched_barrier(0)
    Unit cur, nxt; int ui = 0;
    if (!S.next(0, cur)) return;
    f32x4 acc[2][2][4][2];
#pragma unroll
    for (int a = 0; a < 2; ++a)
#pragma unroll
        for (int b = 0; b < 2; ++b)
#pragma unroll
            for (int m = 0; m < 4; ++m)
#pragma unroll
                for (int n = 0; n < 2; ++n) acc[a][b][m][n] = (f32x4){0.f, 0.f, 0.f, 0.f};
    bf16x8 At[4][2], B0[2][2], B1[2][2];
    const char* cA = (cur.kind ? (const char*)g.A2 : (const char*)g.A + (size_t)cur.pm * tstep) + (size_t)cur.kt0 * kstep; const char* cB = (const char*)g.Bt + (size_t)cur.pn * tstep + (size_t)cur.kt0 * kstep;
    S.a_ready(cur);
    PG8_STAGE(PG8_SB(0, 0), cB, voffB); PG8_STAGE(PG8_SA(0, 0), cA, voffA); PG8_STAGE(PG8_SB(0, 1), cB + hstep, voffB); PG8_STAGE(PG8_SA(0, 1), cA + hstep, voffA);
    if (wr == 1) PG8_BAR;
    PG8_WAIT_V(4); PG8_BAR;
    PG8_STAGE(PG8_SB(1, 0), cB + kstep, voffB); PG8_STAGE(PG8_SA(1, 0), cA + kstep, voffA); PG8_STAGE(PG8_SB(1, 1), cB + hstep + kstep, voffB);
    PG8_WAIT_V(6); PG8_BAR;
    for (;;) {
        const bool has_next = S.next(ui + 1, nxt);
        const char* nA = has_next ? (nxt.kind ? (const char*)g.A2 : (const char*)g.A + (size_t)nxt.pm * tstep) + (size_t)nxt.kt0 * kstep : cA; const char* nB = has_next ? (const char*)g.Bt + (size_t)nxt.pn * tstep + (size_t)nxt.kt0 * kstep : cB;
        const int nt = cur.nt;
        for (int t = 0; t < nt; t += 2) {
            const bool last = (t == nt - 2);
            const char* a1 = cA + (size_t)(t + 1) * kstep;
            const char* a2 = last ? nA : cA + (size_t)(t + 2) * kstep; const char* b2 = last ? nB : cB + (size_t)(t + 2) * kstep;
            const char* a3 = a2 + kstep; const char* b3 = b2 + kstep;
            if (last && has_next) S.a_ready(nxt);
            PG8_LDB(B0, 0, 0); PG8_SCHED; PG8_LDA(At, 0, 0); PG8_STAGE(PG8_SA(1, 1), a1 + hstep, voffA);
            PG8_WAIT_L(8); PG8_BAR; PG8_WAIT_L(0); PG8_MMA(0, 0, At, B0); PG8_BAR; PG8_SCHED;
            PG8_LDB(B1, 0, 1); PG8_STAGE(PG8_SB(0, 0), b2, voffB);
            PG8_BAR; PG8_WAIT_L(0); PG8_MMA(0, 1, At, B1); PG8_BAR;
            PG8_LDA(At, 0, 1); PG8_STAGE(PG8_SA(0, 0), a2, voffA);
            PG8_BAR; PG8_WAIT_L(0); PG8_MMA(1, 0, At, B0); PG8_BAR; PG8_SCHED;
            PG8_STAGE(PG8_SB(0, 1), b2 + hstep, voffB);
            PG8_WAIT_V(6); PG8_BAR; PG8_MMA(1, 1, At, B1); PG8_BAR;
            PG8_LDB(B0, 1, 0); PG8_SCHED; PG8_LDA(At, 1, 0); PG8_STAGE(PG8_SA(0, 1), a2 + hstep, voffA);
            PG8_WAIT_L(8); PG8_BAR; PG8_WAIT_L(0); PG8_MMA(0, 0, At, B0); PG8_BAR; PG8_SCHED;
            PG8_LDB(B1, 1, 1); PG8_STAGE(PG8_SB(1, 0), b3, voffB);
            PG8_BAR; PG8_WAIT_L(0); PG8_MMA(0, 1, At, B1); PG8_BAR;
            PG8_LDA(At, 1, 1); PG8_STAGE(PG8_SA(1, 0), a3, voffA);
            PG8_BAR; PG8_WAIT_L(0); PG8_MMA(1, 0, At, B0); PG8_BAR; PG8_SCHED;
            PG8_STAGE(PG8_SB(1, 1), b3 + hstep, voffB);
            PG8_WAIT_V(6); PG8_BAR; PG8_MMA(1, 1, At, B1); PG8_BAR;
        }
        E(acc, cur, wr, wc, fr, fq); S.done(cur);
        if (!has_next) break;
#pragma unroll
        for (int a = 0; a < 2; ++a)
#pragma unroll
            for (int b = 0; b < 2; ++b)
#pragma unroll
                for (int m = 0; m < 4; ++m)
#pragma unroll
                    for (int n = 0; n < 2; ++n) acc[a][b][m][n] = (f32x4){0.f, 0.f, 0.f, 0.f};
        cur = nxt; cA = nA; cB = nB; ++ui;
    }
    PG8_WAIT_V(0);
    if (wr == 0) PG8_BAR;
    PG8_BAR;
#undef PG8_SA
#undef PG8_SB
#undef PG8_STAGE
#undef PG8_LDA
#undef PG8_LDB
#undef PG8_MMA
#undef PG8_WAIT_V
#undef PG8_WAIT_L
#undef PG8_BAR
#undef PG8_SCHED
}
}
using pg8::Unit;

constexpr int RSL_OFF = 131072;
template <class Sched> DI void prep_rstd(unsigned char* smem, const float* __restrict__ ssq, int np, const Sched& S, const void* conv) {
    float* rsl = (float*)(smem + RSL_OFF);
    int* upm = (int*)(smem + RSL_OFF + 8 * 256 * 4);
    const int tid = threadIdx.x, lane = tid & 63, wid = tid >> 6;
    int nu = 0;
    {
        Unit u;
#pragma unroll 1
        for (int i = 0; i < 8 && S.next(i, u); ++i) {
            const bool cv = (u.kind == 1) && (conv != nullptr);
            if (tid == 0) upm[i] = cv ? -1 : u.pm;
            if (cv) {
                const bf16_t* xbs = (const bf16_t*)conv;
#pragma unroll 8
                for (int rr = 0; rr < 16; ++rr) {
                    const int r = rr * 8 + wid;
                    const bf16_t* src = xbs + tm_off((size_t)TP + r, 16 * lane, DM);
                    const bf16x8 v0 = *(const bf16x8*)src, v1 = *(const bf16x8*)(src + 8);
                    float ss = 0.f;
#pragma unroll
                    for (int e = 0; e < 8; ++e) { const float x0 = bf2f(v0[e]), x1 = bf2f(v1[e]); ss += x0 * x0 + x1 * x1; }
#pragma unroll
                    for (int o = 32; o >= 1; o >>= 1) ss += __shfl_xor(ss, o);
                    if (lane == 0) rsl[i * 256 + r] = rsqrtf(ss * (1.f / DM) + EPS);
                }
                if (tid < 128) rsl[i * 256 + 128 + tid] = 0.f;
            }
            nu = i + 1;
        }
    }
    __syncthreads();
    if (np == 16) {
        for (int idx = tid; idx < nu * 256; idx += 512) {
            const int i = idx >> 8, r = idx & 255, pm = upm[i];
            if (pm < 0) continue;
            const float* p = ssq + (size_t)pm * 256 + r;
            float v[16];
#pragma unroll
            for (int q = 0; q < 16; ++q) v[q] = p[(size_t)q * MP];
            float s = 0.f;
#pragma unroll
            for (int q = 0; q < 16; ++q) s += v[q];
            rsl[idx] = rsqrtf(s * (1.f / DM) + EPS);
        }
    } else {
        for (int idx = tid; idx < nu * 256; idx += 512) {
            const int i = idx >> 8, r = idx & 255, pm = upm[i];
            if (pm < 0) continue;
            rsl[idx] = rsqrtf(ssq[(size_t)pm * 256 + r] * (1.f / DM) + EPS);
        }
    }
    __syncthreads();
    asm volatile("" ::: "memory");
}
struct EpiSwiGLU {
    static constexpr bool PERM = true;
    bf16_t* act; const LAS float* rsl;
    DI void operator()(const f32x4 (&acc)[2][2][4][2], const Unit& u, int wr, int wc, int fr, int fq) const {
        const int row0 = u.pm * 256 + wr * 64 + fr, col0 = u.pn * 128 + wc * 32 + 8 * fq;
#pragma unroll
        for (int ai = 0; ai < 2; ++ai)
#pragma unroll
            for (int m = 0; m < 4; ++m) {
                const int row = row0 + ai * 128 + m * 16; const float rs = rsl[u.ui * 256 + wr * 64 + fr + ai * 128 + m * 16];
                float o[8];
#pragma unroll
                for (int n = 0; n < 2; ++n)
#pragma unroll
                    for (int i = 0; i < 4; ++i) { const float gv = acc[ai][0][m][n][i] * rs, uv = acc[ai][1][m][n][i] * rs; o[n * 4 + i] = gv * __builtin_amdgcn_rcpf(1.f + __expf(-gv)) * uv; }
                *(bf16x8*)(act + tm_off(row, col0, FF)) = pack8(o);
                asm volatile("" ::: "memory");
            }
    }
};
struct EpiRowScale {
    static constexpr bool PERM = true;
    bf16_t* O; int ldo; const LAS float* rsl;
    DI void operator()(const f32x4 (&acc)[2][2][4][2], const Unit& u, int wr, int wc, int fr, int fq) const {
        const int row0 = u.pm * 256 + wr * 64 + fr, col0 = u.pn * 256 + wc * 32 + 8 * fq;
#pragma unroll
        for (int ai = 0; ai < 2; ++ai)
#pragma unroll
            for (int m = 0; m < 4; ++m) {
                const int row = row0 + ai * 128 + m * 16; const float rs = rsl[u.ui * 256 + wr * 64 + fr + ai * 128 + m * 16];
#pragma unroll
                for (int bj = 0; bj < 2; ++bj) {
                    float o[8];
#pragma unroll
                    for (int n = 0; n < 2; ++n)
#pragma unroll
                        for (int i = 0; i < 4; ++i) o[n * 4 + i] = acc[ai][bj][m][n][i] * rs;
                    *(bf16x8*)(O + pj(row, col0 + bj * 128)) = pack8(o);
                }
                asm volatile("" ::: "memory");
            }
    }
};
template <bool LAST> struct EpiResid {
    static constexpr bool PERM = false;
    float* out; float scale; bf16_t* xb; float* ssqp;
    DI void operator()(const f32x4 (&acc)[2][2][4][2], const Unit& u, int wr, int wc, int fr, int fq) const {
        const int col0 = u.pn * 256 + wc * 32 + 4 * fq;
        if (u.kind == 2) {
#pragma unroll
            for (int m = 0; m < 4; ++m) {
                float* op = out + (size_t)(TP + wr * 64 + m * 16 + fr) * DM + col0;
#pragma unroll
                for (int bj = 0; bj < 2; ++bj)
#pragma unroll
                    for (int n = 0; n < 2; ++n)
#pragma unroll
                        for (int i = 0; i < 4; ++i) __hip_atomic_fetch_add(op + bj * 128 + n * 16 + i, scale * acc[0][bj][m][n][i], __ATOMIC_RELAXED, __HIP_MEMORY_SCOPE_AGENT);
                asm volatile("" ::: "memory");
            }
            return;
        }
        const int row0 = u.pm * 256 + wr * 64 + fr;
#pragma unroll
        for (int ai = 0; ai < 2; ++ai) {
            bf16x4 rb[4][2][2];
#pragma unroll
            for (int m = 0; m < 4; ++m)
#pragma unroll
                for (int bj = 0; bj < 2; ++bj)
#pragma unroll
                    for (int n = 0; n < 2; ++n) rb[m][bj][n] = *(const bf16x4*)(xb + tm_off(row0 + ai * 128 + m * 16, col0 + bj * 128 + n * 16, DM));
#pragma unroll
            for (int m = 0; m < 4; ++m) {
                const int row = row0 + ai * 128 + m * 16;
                float ss = 0.f;
#pragma unroll
                for (int bj = 0; bj < 2; ++bj)
#pragma unroll
                    for (int n = 0; n < 2; ++n) {
                        const int c = col0 + bj * 128 + n * 16;
                        bf16_t* xp4 = xb + tm_off(row, c, DM);
                        const bf16x4 r4 = rb[m][bj][n];
                        const f32x4 r = {bf2f(r4[0]), bf2f(r4[1]), bf2f(r4[2]), bf2f(r4[3])};
                        const f32x4 o = r + scale * acc[ai][bj][m][n];
                        if (LAST) *(f32x4*)(out + (size_t)row * DM + c) = o;
                        else { ss += o[0] * o[0] + o[1] * o[1] + o[2] * o[2] + o[3] * o[3];
                            u32x2 pk; pk[0] = pk_bf16(o[0], o[1]); pk[1] = pk_bf16(o[2], o[3]); *(u32x2*)xp4 = pk; }
                    }
                if (!LAST) { ss += __shfl_xor(ss, 16); ss += __shfl_xor(ss, 32); if (fq == 0) ssqp[(size_t)(u.pn * 4 + wc) * MP + row] = ss; }
            }
            asm volatile("" ::: "memory");
        }
    }
};

DI void convert_unit(float* tl, const float* __restrict__ W, int ldw, int k0, int srccol0, const float* __restrict__ gain, bf16_t* __restrict__ Wt, int ldk, int dstrow0) {
    const int tid = threadIdx.x;
    f32x4 v[8]; float g[8];
#pragma unroll
    for (int i = 0; i < 8; ++i) {
        const int kk = (tid >> 4) + 32 * i, c4 = (tid & 15) * 4;
        v[i] = *(const f32x4*)(W + (size_t)(k0 + kk) * ldw + srccol0 + c4);
        g[i] = gain ? gain[k0 + kk] : 1.f;
    }
#pragma unroll
    for (int i = 0; i < 8; ++i) {
        const int kk = (tid >> 4) + 32 * i, c4 = (tid & 15) * 4;
#pragma unroll
        for (int j = 0; j < 4; ++j) tl[kk * 65 + c4 + j] = v[i][j] * g[i];
    }
    __syncthreads();
#pragma unroll
    for (int i = 0; i < 4; ++i) {
        const int id = tid + 512 * i, n = id & 63, kc = (id >> 6) * 8; float f[8];
#pragma unroll
        for (int e = 0; e < 8; ++e) f[e] = tl[(kc + e) * 65 + n];
        *(bf16x8*)(Wt + tm_off(dstrow0 + n, k0 + kc, ldk)) = pack8(f);
    }
    __syncthreads();
}
DI void convert_weight_unit(const Params& P, float* tl, int id) {
    if (id < 352 || (id >= 768 && id < 1120)) {
        const bool second = id >= 768; if (second) id -= 768;
        const int ntile = id % 88, kt = id / 88, dstrow0 = ntile * 64, pn = dstrow0 >> 8, hh = (dstrow0 >> 7) & 1, j0 = dstrow0 & 127;
        const float* W = second ? (hh ? P.wu2 : P.wg2) : (hh ? P.wu1 : P.wg1);
        convert_unit(tl, W, FF, kt * 256, pn * 128 + j0, second ? P.g2 : P.g1, (bf16_t*)(P.ws + (second ? O_WGU2 : O_WGU1)), DM, dstrow0);
    } else if (id < 528 || id >= 1120) {
        const bool second = id >= 1120; id -= second ? 1120 : 352;
        const int ntile = id % 16, kt = id / 16;
        convert_unit(tl, second ? P.wd2 : P.wd1, DM, kt * 256, ntile * 64, nullptr, (bf16_t*)(P.ws + (second ? O_WD2 : O_WD1)), FF, ntile * 64);
    } else if (id < 704) {
        id -= 528; const int ntile = id % 44, kt = id / 44, dstrow0 = ntile * 64;
        convert_unit(tl, P.win, WIN_LD, kt * 256, dstrow0 < 2048 ? dstrow0 : dstrow0 + 8, P.gmix, (bf16_t*)(P.ws + O_WIN), DM, dstrow0);
    } else {
        id -= 704; const int ntile = id % 16, kt = id / 16;
        convert_unit(tl, P.wout, DM, kt * 256, ntile * 64, nullptr, (bf16_t*)(P.ws + O_WOUT), DM, ntile * 64);
    }
}
struct WDesc { const float* W; const float* gain; bf16_t* Wt; int ldw, k0, srccol0, ldk, dstrow0; };
DI WDesc wdesc(const Params& P, int id) {
    WDesc d;
    if (id < 352 || (id >= 768 && id < 1120)) {
        const bool second = id >= 768; if (second) id -= 768;
        const int ntile = id % 88, kt = id / 88, dstrow0 = ntile * 64, pn = dstrow0 >> 8, hh = (dstrow0 >> 7) & 1, j0 = dstrow0 & 127;
        d.W = second ? (hh ? P.wu2 : P.wg2) : (hh ? P.wu1 : P.wg1); d.gain = second ? P.g2 : P.g1; d.Wt = (bf16_t*)(P.ws + (second ? O_WGU2 : O_WGU1));
        d.ldw = FF; d.k0 = kt * 256; d.srccol0 = pn * 128 + j0; d.ldk = DM; d.dstrow0 = dstrow0;
    } else if (id < 528 || id >= 1120) {
        const bool second = id >= 1120; id -= second ? 1120 : 352;
        const int ntile = id % 16, kt = id / 16;
        d.W = second ? P.wd2 : P.wd1; d.gain = nullptr; d.Wt = (bf16_t*)(P.ws + (second ? O_WD2 : O_WD1)); d.ldw = DM; d.k0 = kt * 256; d.srccol0 = ntile * 64; d.ldk = FF; d.dstrow0 = ntile * 64;
    } else if (id < 704) {
        id -= 528; const int ntile = id % 44, kt = id / 44, dstrow0 = ntile * 64;
        d.W = P.win; d.gain = P.gmix; d.Wt = (bf16_t*)(P.ws + O_WIN); d.ldw = WIN_LD; d.k0 = kt * 256; d.srccol0 = dstrow0 < 2048 ? dstrow0 : dstrow0 + 8; d.ldk = DM; d.dstrow0 = dstrow0;
    } else {
        id -= 704; const int ntile = id % 16, kt = id / 16;
        d.W = P.wout; d.gain = nullptr; d.Wt = (bf16_t*)(P.ws + O_WOUT); d.ldw = DM; d.k0 = kt * 256; d.srccol0 = ntile * 64; d.ldk = DM; d.dstrow0 = ntile * 64;
    }
    return d;
}
DI void p0_load(const Params& P, int t, int nW, f32x4 (&v)[8], float (&g)[8]) {
    const int tid = threadIdx.x, lane = tid & 63, wid = tid >> 6;
    if (t < nW) {
        const WDesc d = wdesc(P, t);
#pragma unroll
        for (int i = 0; i < 8; ++i) {
            const int kk = (tid >> 4) + 32 * i, c4 = (tid & 15) * 4;
            v[i] = __builtin_nontemporal_load((const f32x4*)(d.W + (size_t)(d.k0 + kk) * d.ldw + d.srccol0 + c4));
            g[i] = d.gain ? d.gain[d.k0 + kk] : 1.f;
        }
    } else {
        const int id = t - nW;
#pragma unroll
        for (int rr = 0; rr < 2; ++rr) {
            const int row = id * 16 + rr * 8 + wid;
            const float* src = row < TP ? P.xp + (size_t)row * DM : P.xs + (size_t)(row - TP) * DM;
#pragma unroll
            for (int i = 0; i < 4; ++i) v[rr * 4 + i] = __builtin_nontemporal_load((const f32x4*)(src + i * 256 + lane * 4));
        }
    }
}
DI void p0_proc(const Params& P, float* tl, int t, int nW, const f32x4 (&v)[8], const float (&g)[8]) {
    const int tid = threadIdx.x, lane = tid & 63, wid = tid >> 6;
    if (t < nW) {
        const WDesc d = wdesc(P, t);
#pragma unroll
        for (int i = 0; i < 8; ++i) {
            const int kk = (tid >> 4) + 32 * i, c4 = (tid & 15) * 4;
#pragma unroll
            for (int j = 0; j < 4; ++j) tl[kk * 65 + c4 + j] = v[i][j] * g[i];
        }
        __syncthreads();
#pragma unroll
        for (int i = 0; i < 4; ++i) {
            const int id = tid + 512 * i, n = id & 63, kc = (id >> 6) * 8; float f[8];
#pragma unroll
            for (int e = 0; e < 8; ++e) f[e] = tl[(kc + e) * 65 + n];
            *(bf16x8*)(d.Wt + tm_off(d.dstrow0 + n, d.k0 + kc, d.ldk)) = pack8(f);
        }
        __syncthreads();
    } else {
        bf16_t* xb = (bf16_t*)(P.ws + O_XB); float* ssq = (float*)(P.ws + O_SSQ);
        const int id = t - nW;
#pragma unroll
        for (int rr = 0; rr < 2; ++rr) {
            const int row = id * 16 + rr * 8 + wid;
            float ss = 0.f;
#pragma unroll
            for (int i = 0; i < 4; ++i) {
                const f32x4 x = v[rr * 4 + i];
                ss += x[0] * x[0] + x[1] * x[1] + x[2] * x[2] + x[3] * x[3];
                u32x2 pk; pk[0] = pk_bf16(x[0], x[1]); pk[1] = pk_bf16(x[2], x[3]);
                *(u32x2*)(xb + tm_off(row, i * 256 + lane * 4, DM)) = pk;
                if (row >= TP) *(f32x4*)(P.out + (size_t)row * DM + i * 256 + lane * 4) = x;
            }
#pragma unroll
            for (int o = 32; o >= 1; o >>= 1) ss += __shfl_xor(ss, o);
            if (lane == 0) ssq[row] = ss;
        }
    }
}
DI void phase0(const Params& P, unsigned char* smem) {
    float* tl = (float*)smem;
    const int nW = (gridDim.x == 256) ? 352 : 1296, N = nW + 1032, G = gridDim.x;
    f32x4 va[8], vb[8]; float ga[8], gb[8];
    int t = blockIdx.x;
    if (t < N) p0_load(P, t, nW, va, ga);
    while (t < N) {
        int t2 = t + G;
        if (t2 < N) p0_load(P, t2, nW, vb, gb);
        p0_proc(P, tl, t, nW, va, ga);
        t = t2; if (t >= N) break;
        t2 = t + G;
        if (t2 < N) p0_load(P, t2, nW, va, ga);
        p0_proc(P, tl, t, nW, vb, gb);
        t = t2;
    }
}

DI void gates_pass(const Params& P, unsigned char* smem) {
    bf16_t* wg = (bf16_t*)smem;
    float* lss = (float*)(smem + 16 * 1032 * 2);
    const int tid = threadIdx.x, lane = tid & 63, wid = tid >> 6, fr = lane & 15, fq = lane >> 4;
#pragma unroll
    for (int j = 0; j < 2; ++j) {
        const int k = tid + 512 * j; const float g = P.gmix[k];
        const f32x4 v0 = *(const f32x4*)(P.win + (size_t)k * WIN_LD + 2048), v1 = *(const f32x4*)(P.win + (size_t)k * WIN_LD + 2052);
#pragma unroll
        for (int n = 0; n < 4; ++n) { wg[n * 1032 + k] = (bf16_t)f2bf(v0[n] * g); wg[(4 + n) * 1032 + k] = (bf16_t)f2bf(v1[n] * g); }
#pragma unroll
        for (int n = 8; n < 16; ++n) wg[n * 1032 + k] = (bf16_t)0;
    }
    __syncthreads();
    float* gates = (float*)(P.ws + O_GATE);
    const bf16_t* xb = (const bf16_t*)(P.ws + O_XB);
    for (int tile = blockIdx.x * 8 + wid; tile < MV / 16; tile += gridDim.x * 8) {
        const int row = tile * 16 + fr;
        f32x4 acc = {0.f, 0.f, 0.f, 0.f}; float ss = 0.f;
        if (true) {
            const bf16_t* src = xb + tm_off(row, 0, DM) + 8 * fq;
#pragma unroll 16
            for (int ks = 0; ks < 32; ++ks) {
                const bf16x8 a = *(const bf16x8*)(src + (size_t)(ks >> 1) * 16384 + (ks & 1) * 32);
                const bf16x8 bw = *(const bf16x8*)(wg + fr * 1032 + 32 * ks + 8 * fq);
#pragma unroll
                for (int e = 0; e < 8; ++e) { const float x = bf2f(a[e]); ss += x * x; }
                acc = MFMA16(a, bw, acc);
            }
        } else {
            const float* src = P.out + (size_t)row * DM + 8 * fq;
#pragma unroll 4
            for (int ks = 0; ks < 32; ++ks) {
                const f32x4 x0 = *(const f32x4*)(src + 32 * ks), x1 = *(const f32x4*)(src + 32 * ks + 4);
                float f[8] = {x0[0], x0[1], x0[2], x0[3], x1[0], x1[1], x1[2], x1[3]};
#pragma unroll
                for (int e = 0; e < 8; ++e) ss += f[e] * f[e];
                const bf16x8 a = pack8(f);
                const bf16x8 bw = *(const bf16x8*)(wg + fr * 1032 + 32 * ks + 8 * fq);
                acc = MFMA16(a, bw, acc);
            }
        }
        ss += __shfl_xor(ss, 16); ss += __shfl_xor(ss, 32);
        if (fq == 0) lss[wid * 16 + fr] = rsqrtf(ss * (1.f / DM) + EPS);
        if (fr < 8) {
            const float bias = (fr < 4) ? P.bi[fr] : P.bfg[fr - 4];
#pragma unroll
            for (int r = 0; r < 4; ++r) {
                const float v = acc[r] * lss[wid * 16 + 4 * fq + r] + bias;
                const float o = (fr < 4) ? v : (fminf(v, 0.f) - log1pf(expf(-fabsf(v))));
                gates[(size_t)(tile * 16 + 4 * fq + r) * 8 + fr] = o;
            }
        }
    }
    __syncthreads();
}

DI size_t pj(size_t row, int col) {
    return col < 2048 ? ((size_t)(col >> 7) * MP + row) * 128 + (col & 127)
                      : (size_t)16 * MP * 128 + ((size_t)((col - 2048) >> 6) * MP + row) * 64 + (col & 63);
}
constexpr int C_QM = 0, C_KM = 512, C_VM = 1024, C_OM = 1536, C_QA = 2048, C_KA = 2560, C_VA = 2688;

DI float cumsum128(float v, float* red) {
    const int tid = threadIdx.x, lane = tid & 63;
    float cs = v;
#pragma unroll
    for (int o = 1; o < 64; o <<= 1) { const float t = __shfl_up(cs, o); if (lane >= o) cs += t; }
    if (tid == 63) red[0] = cs;
    __syncthreads();
    if (tid >= 64 && tid < 128) cs += red[0];
    __syncthreads();
    return cs;
}
DI float cummax128(float v, float* red) {
    const int tid = threadIdx.x, lane = tid & 63;
    float cs = v;
#pragma unroll
    for (int o = 1; o < 64; o <<= 1) { const float t = __shfl_up(cs, o); if (lane >= o) cs = fmaxf(cs, t); }
    if (tid == 63) red[0] = cs;
    __syncthreads();
    if (tid >= 64 && tid < 128) cs = fmaxf(cs, red[0]);
    __syncthreads();
    return cs;
}

template <int V> DI void m1_item(const Params& P, unsigned char* smem, int item) {
    const int tid = threadIdx.x, lane = tid & 63, wid = tid >> 6, fr = lane & 15, fq = lane >> 4;
    const int c = item & 31, bh = item >> 5, h = bh & 3, b = bh >> 2;
    const size_t row0 = (size_t)b * 4096 + c * 128;
    const bf16_t* proj = (const bf16_t*)(P.ws + O_BIG);
    const float* gates = (const float*)(P.ws + O_GATE);
    bf16_t* Vt = (bf16_t*)smem;
    bf16_t* Kt = Vt + 128 * 136;
    float* fw = (float*)(smem + 2 * 128 * 136 * 2);
    float* red = fw + 128;
    float ip = 0.f, lf = 0.f;
    if (tid < 128) { ip = gates[(row0 + tid) * 8 + h]; lf = gates[(row0 + tid) * 8 + 4 + h]; }
    bf16x8 kreg[4], vreg[4];
#pragma unroll
    for (int i = 0; i < 4; ++i) {
        const int s = tid & 127, dg = (tid >> 7) + 4 * i;
        kreg[i] = *(const bf16x8*)(proj + pj(row0 + s, C_KM + h * 128 + dg * 8));
        vreg[i] = *(const bf16x8*)(proj + pj(row0 + s, C_VM + h * 128 + dg * 8));
    }
    const float cs = cumsum128(lf, red);
    if (tid == 127) red[1] = cs;
    __syncthreads();
    const float blast = red[1];
    const float le = (tid < 128) ? blast - cs + ip : -INFINITY;
    float mx = le;
#pragma unroll
    for (int o = 32; o >= 1; o >>= 1) mx = fmaxf(mx, __shfl_xor(mx, o));
    if (lane == 0 && wid < 2) red[2 + wid] = mx;
    __syncthreads();
    const float mloc = fmaxf(red[2], red[3]);
    if (tid < 128) fw[tid] = __expf(le - mloc);
    __syncthreads();
#pragma unroll
    for (int i = 0; i < 4; ++i) {
        const int s = tid & 127, dg = (tid >> 7) + 4 * i;
        const bf16x8 kv = kreg[i], vv = vreg[i];
        const float w = fw[s];
#pragma unroll
        for (int e = 0; e < 8; ++e) { Kt[(dg * 8 + e) * 136 + s] = kv[e]; Vt[(dg * 8 + e) * 136 + s] = f2bf(bf2f(vv[e]) * w); }
    }
    __syncthreads();
    if (V == 1) { __syncthreads(); return; }
    f32x4 acc[8];
#pragma unroll
    for (int kt = 0; kt < 8; ++kt) acc[kt] = (f32x4){0.f, 0.f, 0.f, 0.f};
#pragma unroll
    for (int ss = 0; ss < 4; ++ss) {
        const bf16x8 bfrag = *(const bf16x8*)(Vt + (16 * wid + fr) * 136 + 32 * ss + 8 * fq);
#pragma unroll
        for (int kt = 0; kt < 8; ++kt) {
            const bf16x8 afrag = *(const bf16x8*)(Kt + (16 * kt + fr) * 136 + 32 * ss + 8 * fq);
            acc[kt] = MFMA16(afrag, bfrag, acc[kt]);
        }
    }
    bf16_t* dC = (bf16_t*)P.out + (size_t)item * 16384;
#pragma unroll
    for (int kt = 0; kt < 8; ++kt) { const f32x4 a = acc[kt] * KSCALE; u32x2 pk; pk[0] = pk_bf16(a[0], a[1]); pk[1] = pk_bf16(a[2], a[3]);
        *(u32x2*)(dC + (16 * wid + fr) * 128 + 16 * kt + 4 * fq) = pk; }
    { const int k = tid >> 2, part = tid & 3; float sum = 0.f;
      for (int s = 32 * part; s < 32 * part + 32; ++s) sum += fw[s] * bf2f(Kt[k * 136 + s]);
      sum += __shfl_xor(sum, 1); sum += __shfl_xor(sum, 2);
      if (part == 0) ((float*)(P.ws + O_DN))[(size_t)item * 128 + k] = sum * KSCALE; }
    if (tid == 0) { ((float*)(P.ws + O_ML))[item] = mloc; ((float*)(P.ws + O_BL))[item] = blast; }
    __syncthreads();
}

DI void scan_phase(const Params& P, unsigned char* smem) {
    const bf16_t* __restrict__ dC = (const bf16_t*)P.out;
    const float* __restrict__ dn = (const float*)(P.ws + O_DN);
    const float* __restrict__ ml = (const float*)(P.ws + O_ML);
    const float* __restrict__ bl = (const float*)(P.ws + O_BL);
    bf16_t* __restrict__ cst = (bf16_t*)(P.ws + O_CST);
    float* __restrict__ nst = (float*)(P.ws + O_NST);
    float* __restrict__ mst = (float*)(P.ws + O_MST);
    float* ldec = (float*)smem; float* lwi = ldec + 32;
    const int tid = threadIdx.x;
    for (int blk = blockIdx.x; blk < 256; blk += gridDim.x) {
        const int bh = blk >> 4;
        if (tid < 32) { ldec[64 + tid] = bl[bh * 32 + tid]; ldec[96 + tid] = ml[bh * 32 + tid]; }
        __syncthreads();
        if (tid == 0) {
            float m = 0.f;
            for (int c = 0; c < 32; ++c) {
                const int item = bh * 32 + c; const float blc = ldec[64 + c], mlc = ldec[96 + c];
                const float mn = fmaxf(blc + m, mlc);
                ldec[c] = __expf(blc + m - mn); lwi[c] = __expf(mlc - mn);
                if ((blk & 15) == 0) mst[item] = m;
                m = mn;
            }
            if ((blk & 15) == 0) P.out[OUT_PM + bh] = m;
        }
        __syncthreads();
        {
            const int e2 = (blk & 15) * 1024 + tid * 2;
            const bf16_t* src = dC + (size_t)bh * 32 * 16384 + e2;
            bf16_t* dst = cst + (size_t)bh * 32 * 16384 + e2;
            f32x2 C = {0.f, 0.f};
#pragma unroll 1
            for (int c0 = 0; c0 < 32; c0 += 8) {
                f32x2 d[8];
#pragma unroll
                for (int j = 0; j < 8; ++j) { const unsigned w = __builtin_nontemporal_load((const unsigned*)(src + (size_t)(c0 + j) * 16384)); d[j][0] = __uint_as_float(w << 16); d[j][1] = __uint_as_float(w & 0xffff0000u); }
#pragma unroll
                for (int j = 0; j < 8; ++j) {
                    *(unsigned*)(dst + (size_t)(c0 + j) * 16384) = pk_bf16(C[0], C[1]);
                    C = ldec[c0 + j] * C + lwi[c0 + j] * d[j];
                }
            }
            *(f32x2*)(P.out + OUT_PC + (size_t)bh * 16384 + e2) = C;
        }
        if ((blk & 15) == 1 && tid < 128) {
            float n = 0.f;
#pragma unroll 1
            for (int c0 = 0; c0 < 32; c0 += 8) {
                float d[8];
#pragma unroll
                for (int j = 0; j < 8; ++j) d[j] = dn[(size_t)(bh * 32 + c0 + j) * 128 + tid];
#pragma unroll
                for (int j = 0; j < 8; ++j) { nst[(size_t)(bh * 32 + c0 + j) * 128 + tid] = n; n = ldec[c0 + j] * n + lwi[c0 + j] * d[j]; }
            }
            P.out[OUT_PN + (size_t)bh * 128 + tid] = n;
        }
        __syncthreads();
    }
}

template <int V> DI void m3_item(const Params& P, unsigned char* smem, int item) {
    const int tid = threadIdx.x, lane = tid & 63, wid = __builtin_amdgcn_readfirstlane(tid >> 6), fr = lane & 15, fq = lane >> 4;
    const int c = item & 31, bh = item >> 5, h = bh & 3, b = bh >> 2;
    const size_t row0 = (size_t)b * 4096 + c * 128;
    const bf16_t* proj = (const bf16_t*)(P.ws + O_BIG);
    const float* gates = (const float*)(P.ws + O_GATE);
    bf16_t* Ks = (bf16_t*)smem;
    bf16_t* Vt = Ks + 128 * 136;
    bf16_t* C0 = Vt + 128 * 136;
    float* fb = (float*)(smem + 3 * 128 * 136 * 2);
    float* fg = fb + 128;
    float* fpm = fg + 128;
    float* fn = fpm + 128;
    float* red = fn + 128;
    float ip = 0.f, lf = 0.f, n0v = 0.f;
    if (tid < 128) { ip = gates[(row0 + tid) * 8 + h]; lf = gates[(row0 + tid) * 8 + 4 + h]; n0v = ((const float*)(P.ws + O_NST))[(size_t)item * 128 + tid]; }
    const float m0 = ((const float*)(P.ws + O_MST))[item];
    const bf16_t* cst = (const bf16_t*)(P.ws + O_CST) + (size_t)item * 16384;
    const int t = 16 * wid + fr; const size_t rowt = row0 + t;
    bf16x8 kreg[4], creg[4], vreg[4], Bq[4]; bf16x4 oreg[8];
#pragma unroll
    for (int i = 0; i < 4; ++i) {
        const int id = tid + 512 * i, s = id >> 4, ch = id & 15;
        kreg[i] = *(const bf16x8*)(proj + pj(row0 + s, C_KM + h * 128 + ch * 8));
        creg[i] = *(const bf16x8*)(cst + s * 128 + ch * 8);
        const int s2 = tid & 127, dg = (tid >> 7) + 4 * i;
        vreg[i] = *(const bf16x8*)(proj + pj(row0 + s2, C_VM + h * 128 + dg * 8));
    }
#pragma unroll
    for (int ks = 0; ks < 4; ++ks) Bq[ks] = *(const bf16x8*)(proj + pj(rowt, C_QM + h * 128 + 32 * ks + 8 * fq));
#pragma unroll
    for (int vt = 0; vt < 8; ++vt) oreg[vt] = *(const bf16x4*)(proj + pj(rowt, C_OM + h * 128 + 16 * vt + 4 * fq));
    const float cs = cumsum128(lf, red);
    const float gg = ip - cs;
    const float pm = cummax128(tid < 128 ? gg : -INFINITY, red);
    if (tid < 128) { fb[tid] = cs; fg[tid] = gg; fpm[tid] = pm; fn[tid] = n0v; }
#pragma unroll
    for (int i = 0; i < 4; ++i) {
        const int id = tid + 512 * i, s = id >> 4, ch = id & 15;
        *(bf16x8*)(Ks + s * 136 + ch * 8) = kreg[i];
        *(bf16x8*)(C0 + s * 136 + ch * 8) = creg[i];
        const int s2 = tid & 127, dg = (tid >> 7) + 4 * i;
#pragma unroll
        for (int e = 0; e < 8; ++e) Vt[(dg * 8 + e) * 136 + s2] = vreg[i][e];
    }
    __syncthreads();
    if (V == 1) { __syncthreads(); return; }
    float nq = 0.f;
#pragma unroll
    for (int ks = 0; ks < 4; ++ks)
#pragma unroll
        for (int e = 0; e < 8; ++e) nq += fn[32 * ks + 8 * fq + e] * bf2f(Bq[ks][e]);
    nq += __shfl_xor(nq, 16); nq += __shfl_xor(nq, 32);
    const float Mt = fmaxf(m0, fpm[t]); const float winter = __expf(m0 - Mt);
    f32x4 accP[8];
#pragma unroll
    for (int vt = 0; vt < 8; ++vt) accP[vt] = (f32x4){0.f, 0.f, 0.f, 0.f};
    {
        bf16x8 Bqs[4];
#pragma unroll
        for (int ks = 0; ks < 4; ++ks) { float f[8];
#pragma unroll
            for (int e = 0; e < 8; ++e) f[e] = bf2f(Bq[ks][e]) * winter;
            Bqs[ks] = pack8(f); }
#pragma unroll
        for (int ks = 0; ks < 4; ++ks) {
#pragma unroll
            for (int vt = 0; vt < 8; ++vt) {
                const bf16x8 a = *(const bf16x8*)(C0 + (16 * vt + fr) * 136 + 32 * ks + 8 * fq);
                accP[vt] = MFMA16(a, Bqs[ks], accP[vt]);
            }
            asm volatile("" ::: "memory");
        }
    }
    float psum = 0.f;
    const int npair = (wid >> 1) + 1;
#pragma unroll 1
    for (int p = 0; p < npair; ++p) {
        asm volatile("" ::: "memory");
        f32x4 S0 = {0.f, 0.f, 0.f, 0.f}, S1 = {0.f, 0.f, 0.f, 0.f};
#pragma unroll
        for (int ks = 0; ks < 4; ++ks) {
            const bf16x8 a0 = *(const bf16x8*)(Ks + (32 * p + fr) * 136 + 32 * ks + 8 * fq);
            const bf16x8 a1 = *(const bf16x8*)(Ks + (32 * p + 16 + fr) * 136 + 32 * ks + 8 * fq);
            S0 = MFMA16(a0, Bq[ks], S0); S1 = MFMA16(a1, Bq[ks], S1);
        }
        float pv[8];
#pragma unroll
        for (int r = 0; r < 4; ++r) {
            const int s0 = 32 * p + 4 * fq + r, s1 = s0 + 16;
            const float d0 = (s0 <= t) ? __expf(fg[s0] - Mt) : 0.f;
            const float d1 = (s1 <= t) ? __expf(fg[s1] - Mt) : 0.f;
            pv[r] = (s0 <= t) ? S0[r] * KSCALE * d0 : 0.f; pv[4 + r] = (s1 <= t) ? S1[r] * KSCALE * d1 : 0.f;
            psum += pv[r] + pv[4 + r];
        }
        const bf16x8 Bp = pack8(pv);
#pragma unroll
        for (int vt = 0; vt < 8; ++vt) {
            const bf16x4 lo = *(const bf16x4*)(Vt + (16 * vt + fr) * 136 + 32 * p + 4 * fq);
            const bf16x4 hi = *(const bf16x4*)(Vt + (16 * vt + fr) * 136 + 32 * p + 16 + 4 * fq);
            const bf16x8 a = {lo[0], lo[1], lo[2], lo[3], hi[0], hi[1], hi[2], hi[3]};
            accP[vt] = MFMA16(a, Bp, accP[vt]);
        }
    }
    psum += __shfl_xor(psum, 16); psum += __shfl_xor(psum, 32);
    const float den = winter * nq + psum, mt = fb[t] + Mt;
    const float inv = 1.f / fmaxf(fabsf(den), __expf(-mt));
    float ssq = 0.f;
#pragma unroll
    for (int vt = 0; vt < 8; ++vt)
#pragma unroll
        for (int r = 0; r < 4; ++r) { const float hv = accP[vt][r] * inv; accP[vt][r] = hv; ssq += hv * hv; }
    ssq += __shfl_xor(ssq, 16); ssq += __shfl_xor(ssq, 32);
    const float rn = rsqrtf(ssq * (1.f / 128.f) + EPS);
    bf16_t* ymix = (bf16_t*)(P.ws + O_YMIX);
#pragma unroll
    for (int vt = 0; vt < 8; ++vt) {
        const int v0 = 16 * vt + 4 * fq;
        const bf16x4 o4 = oreg[vt];
        const f32x4 g4 = *(const f32x4*)(P.gout + h * 128 + v0);
        float y[4];
#pragma unroll
        for (int r = 0; r < 4; ++r) y[r] = accP[vt][r] * rn * g4[r] * sigmoidf_(bf2f(o4[r]));
        u32x2 pk; pk[0] = pk_bf16(y[0], y[1]); pk[1] = pk_bf16(y[2], y[3]);
        *(u32x2*)(ymix + tm_off(rowt, h * 128 + v0, DM)) = pk;
    }
    __syncthreads();
}

template <int V> DI void swa_item(const Params& P, unsigned char* smem, int item) {
    const int tid = threadIdx.x, lane = tid & 63, wid = __builtin_amdgcn_readfirstlane(tid >> 6), fr = lane & 15, fq = lane >> 4;
    const int kvh = item & 1, nb = (item >> 1) & 31, b = item >> 6;
    const bf16_t* proj = (const bf16_t*)(P.ws + O_BIG);
    bf16_t* Kn = (bf16_t*)smem;
    bf16_t* Vt = Kn + 256 * 72;
    const long row0 = (long)b * 4096 + (long)(nb - 1) * 128;
    const int qi = 16 * wid + fr;
    const size_t qrow = (size_t)b * 4096 + nb * 128 + qi;
    bf16x8 Qn[2];
#pragma unroll
    for (int ks = 0; ks < 2; ++ks) Qn[ks] = *(const bf16x8*)(proj + pj(qrow, C_QA + (kvh * 4) * 64 + 32 * ks + 8 * fq));
    bf16x8 kraw[4], vraw[4];
#pragma unroll
    for (int i = 0; i < 4; ++i) {
        const int id = tid + 512 * i;
        { const int j = id >> 3, ch = id & 7; const bool valid = (V != 2) && ((nb > 0) || (j >= 128));
          kraw[i] = (bf16x8){0, 0, 0, 0, 0, 0, 0, 0};
          if (valid) kraw[i] = *(const bf16x8*)(proj + pj((size_t)(row0 + j), C_KA + kvh * 64 + ch * 8)); }
        { const int j = id & 255, ch = id >> 8; const bool valid = (V != 2) && ((nb > 0) || (j >= 128));
          vraw[i] = (bf16x8){0, 0, 0, 0, 0, 0, 0, 0};
          if (valid) vraw[i] = *(const bf16x8*)(proj + pj((size_t)(row0 + j), C_VA + kvh * 64 + ch * 8)); }
    }
#pragma unroll
    for (int i = 0; i < 4; ++i) {
        const int id = tid + 512 * i, j = id >> 3, ch = id & 7;
        const bf16x8 kv = kraw[i];
        float f[8]; float ss = 0.f;
#pragma unroll
        for (int e = 0; e < 8; ++e) { f[e] = bf2f(kv[e]); ss += f[e] * f[e]; }
        ss += __shfl_xor(ss, 1); ss += __shfl_xor(ss, 2); ss += __shfl_xor(ss, 4);
        const float rs = rsqrtf(ss * (1.f / 64.f) + EPS);
        const f32x4 g0 = *(const f32x4*)(P.gk + ch * 8), g1 = *(const f32x4*)(P.gk + ch * 8 + 4);
#pragma unroll
        for (int e = 0; e < 4; ++e) { f[e] *= rs * g0[e]; f[4 + e] *= rs * g1[e]; }
        *(bf16x8*)(Kn + j * 72 + ch * 8) = pack8(f);
        if (nb == 31 && j >= 128) {
            float* dst = P.out + OUT_PK + ((size_t)(b * 128 + (j - 128)) * 2 + kvh) * 64 + ch * 8;
            *(f32x4*)dst = (f32x4){f[0], f[1], f[2], f[3]}; *(f32x4*)(dst + 4) = (f32x4){f[4], f[5], f[6], f[7]};
        }
    }
#pragma unroll
    for (int i = 0; i < 4; ++i) {
        const int id = tid + 512 * i, j = id & 255, ch = id >> 8;
        const bf16x8 vv = vraw[i];
#pragma unroll
        for (int e = 0; e < 8; ++e) Vt[(ch * 8 + e) * 264 + j] = vv[e];
        if (nb == 31 && j >= 128) {
            float* dst = P.out + OUT_PV + ((size_t)(b * 128 + (j - 128)) * 2 + kvh) * 64 + ch * 8;
            *(f32x4*)dst = (f32x4){bf2f(vv[0]), bf2f(vv[1]), bf2f(vv[2]), bf2f(vv[3])}; *(f32x4*)(dst + 4) = (f32x4){bf2f(vv[4]), bf2f(vv[5]), bf2f(vv[6]), bf2f(vv[7])};
        }
    }
    __syncthreads();
    bf16_t* ymix = (bf16_t*)(P.ws + O_YMIX);
    const int st0 = 2 * (wid >> 1);
#pragma unroll 1
    for (int hh = 0; hh < 4; ++hh) {
        const int head = kvh * 4 + hh;
        bf16x8 Qc[2] = {Qn[0], Qn[1]};
        if (hh < 3) {
#pragma unroll
            for (int ks = 0; ks < 2; ++ks) Qn[ks] = *(const bf16x8*)(proj + pj(qrow, C_QA + (head + 1) * 64 + 32 * ks + 8 * fq));
        }
        bf16x8 Bq[2];
        { float f[16]; float ss = 0.f;
#pragma unroll
          for (int ks = 0; ks < 2; ++ks) { const bf16x8 q = Qc[ks];
#pragma unroll
              for (int e = 0; e < 8; ++e) { f[ks * 8 + e] = bf2f(q[e]); ss += f[ks * 8 + e] * f[ks * 8 + e]; } }
          ss += __shfl_xor(ss, 16); ss += __shfl_xor(ss, 32);
          const float rs = rsqrtf(ss * (1.f / 64.f) + EPS) * 0.125f;
#pragma unroll
          for (int ks = 0; ks < 2; ++ks) {
              const f32x4 g0 = *(const f32x4*)(P.gq + 32 * ks + 8 * fq), g1 = *(const f32x4*)(P.gq + 32 * ks + 8 * fq + 4);
#pragma unroll
              for (int e = 0; e < 4; ++e) { f[ks * 8 + e] *= rs * g0[e]; f[ks * 8 + 4 + e] *= rs * g1[e]; }
              Bq[ks] = pack8(f + ks * 8);
          } }
        f32x4 S[10];
#pragma unroll
        for (int i = 0; i < 10; ++i) {
            S[i] = (f32x4){0.f, 0.f, 0.f, 0.f};
#pragma unroll
            for (int ks = 0; ks < 2; ++ks) {
                const bf16x8 a = *(const bf16x8*)(Kn + (16 * (st0 + i) + fr) * 72 + 32 * ks + 8 * fq);
                S[i] = MFMA16(a, Bq[ks], S[i]);
            }
            if ((i & 3) == 3) asm volatile("" ::: "memory");
        }
        const float sink = P.sinks[head];
        float mx = sink;
#pragma unroll
        for (int i = 0; i < 10; ++i)
#pragma unroll
            for (int r = 0; r < 4; ++r) {
                const int j = 16 * (st0 + i) + 4 * fq + r;
                const bool ok = (j >= qi) && (j <= qi + 128) && ((nb > 0) || (j >= 128));
                S[i][r] = ok ? S[i][r] : -INFINITY;
                mx = fmaxf(mx, S[i][r]);
            }
        mx = fmaxf(mx, __shfl_xor(mx, 16)); mx = fmaxf(mx, __shfl_xor(mx, 32));
        float sum = 0.f;
#pragma unroll
        for (int i = 0; i < 10; ++i)
#pragma unroll
            for (int r = 0; r < 4; ++r) { const float pe = __expf(S[i][r] - mx); S[i][r] = pe; sum += pe; }
        sum += __shfl_xor(sum, 16); sum += __shfl_xor(sum, 32);
        const float invden = 1.f / (sum + __expf(sink - mx));
        f32x4 O[4];
#pragma unroll
        for (int dt = 0; dt < 4; ++dt) O[dt] = (f32x4){0.f, 0.f, 0.f, 0.f};
#pragma unroll
        for (int pp = 0; pp < 5; ++pp) {
            float pv[8];
#pragma unroll
            for (int r = 0; r < 4; ++r) { pv[r] = S[2 * pp][r]; pv[4 + r] = S[2 * pp + 1][r]; }
            const bf16x8 Bp = pack8(pv);
#pragma unroll
            for (int dt = 0; dt < 4; ++dt) {
                const bf16x4 lo = *(const bf16x4*)(Vt + (16 * dt + fr) * 264 + 16 * (st0 + 2 * pp) + 4 * fq);
                const bf16x4 hi = *(const bf16x4*)(Vt + (16 * dt + fr) * 264 + 16 * (st0 + 2 * pp) + 16 + 4 * fq);
                const bf16x8 a = {lo[0], lo[1], lo[2], lo[3], hi[0], hi[1], hi[2], hi[3]};
                O[dt] = MFMA16(a, Bp, O[dt]);
            }
            asm volatile("" ::: "memory");
        }
#pragma unroll
        for (int dt = 0; dt < 4; ++dt) {
            u32x2 pk; pk[0] = pk_bf16(O[dt][0] * invden, O[dt][1] * invden); pk[1] = pk_bf16(O[dt][2] * invden, O[dt][3] * invden);
            *(u32x2*)(ymix + tm_off(qrow, 512 + head * 64 + 16 * dt + 4 * fq, DM)) = pk;
        }
    }
    __syncthreads();
}

DI void smlstm_item(const Params& P, unsigned char* smem, int item) {
    const int tid = threadIdx.x, lane = tid & 63, wid = tid >> 6;
    const int h = item & 3, b = item >> 2;
    const size_t r = (size_t)TP + b;
    const bf16_t* proj = (const bf16_t*)(P.ws + O_BIG);
    const float* gates = (const float*)(P.ws + O_GATE);
    float* lq = (float*)smem; float* lk = lq + 128; float* lv = lk + 128; float* lcq = lv + 128; float* red = lcq + 128;
    const int sub = tid & 31, vr = tid >> 5;
    const float* __restrict__ Cin = P.sC + (size_t)item * 16384; float* __restrict__ Cout = P.out + OUT_SC + (size_t)item * 16384;
    f32x4 creg[8];
#pragma unroll
    for (int it = 0; it < 8; ++it) creg[it] = __builtin_nontemporal_load((const f32x4*)(Cin + (vr + 16 * it) * 128 + 4 * sub));
    float q = 0.f, k = 0.f, v = 0.f, n0 = 0.f;
    if (tid < 128) {
        q = bf2f(proj[pj(r, C_QM + h * 128 + tid)]); k = bf2f(proj[pj(r, C_KM + h * 128 + tid)]) * KSCALE; v = bf2f(proj[pj(r, C_VM + h * 128 + tid)]);
        n0 = P.sn[(size_t)item * 128 + tid];
        lq[tid] = q; lk[tid] = k; lv[tid] = v;
    }
    float qk = q * k, nq = n0 * q;
#pragma unroll
    for (int o = 32; o >= 1; o >>= 1) { qk += __shfl_xor(qk, o); nq += __shfl_xor(nq, o); }
    if (lane == 0 && wid < 2) { red[wid] = qk; red[2 + wid] = nq; }
    __syncthreads();
    qk = red[0] + red[1]; nq = red[2] + red[3];
    const float ip = gates[r * 8 + h], lf = gates[r * 8 + 4 + h], m0 = P.sm[item];
    const float mnew = fmaxf(lf + m0, ip), decay = __expf(lf + m0 - mnew), wend = __expf(ip - mnew);
    const float score = qk * wend;
    {
        const f32x4 q4 = *(const f32x4*)(lq + 4 * sub), k4 = *(const f32x4*)(lk + 4 * sub);
#pragma unroll
        for (int it = 0; it < 8; ++it) {
            const int vv = vr + 16 * it;
            const f32x4 cc = creg[it];
            float part = cc[0] * q4[0] + cc[1] * q4[1] + cc[2] * q4[2] + cc[3] * q4[3];
            const float wv = wend * lv[vv];
            __builtin_nontemporal_store(decay * cc + wv * k4, (f32x4*)(Cout + vv * 128 + 4 * sub));
#pragma unroll
            for (int o = 16; o >= 1; o >>= 1) part += __shfl_xor(part, o);
            if (sub == 0) lcq[vv] = part;
        }
    }
    __syncthreads();
    float hv = 0.f;
    if (tid < 128) {
        const float num = decay * lcq[tid] + score * v, den = decay * nq + score;
        hv = num / fmaxf(fabsf(den), __expf(-mnew));
        P.out[OUT_SN + (size_t)item * 128 + tid] = decay * n0 + wend * k;
        if (tid == 0) P.out[OUT_SM + item] = mnew;
    }
    float ssq = hv * hv;
#pragma unroll
    for (int o = 32; o >= 1; o >>= 1) ssq += __shfl_xor(ssq, o);
    if (lane == 0 && wid < 2) red[4 + wid] = ssq;
    __syncthreads();
    if (tid < 128) {
        const float rn = rsqrtf((red[4] + red[5]) * (1.f / 128.f) + EPS);
        const float o = bf2f(proj[pj(r, C_OM + h * 128 + tid)]);
        ((bf16_t*)(P.ws + O_YMIX))[tm_off(r, h * 128 + tid, DM)] = (bf16_t)f2bf(hv * rn * P.gout[h * 128 + tid] * sigmoidf_(o));
    }
    __syncthreads();
}

DI void sswa_item(const Params& P, unsigned char* smem, int item) {
    const int tid = threadIdx.x, lane = tid & 63, wid = tid >> 6;
    const int kvh = item & 1, b = item >> 1;
    const size_t r = (size_t)TP + b;
    const bf16_t* proj = (const bf16_t*)(P.ws + O_BIG);
    float* Kc = (float*)smem;
    float* Vc = Kc + 129 * 64;
    float* lq = Vc + 129 * 64;
    float* lp = lq + 256;
    const float* ckb = P.ck + (size_t)b * 16384 + kvh * 64; const float* cvb = P.cv + (size_t)b * 16384 + kvh * 64;
#pragma unroll
    for (int i = 0; i < 4; ++i) {
        const int id = tid + 512 * i, j = id >> 4, q4 = (id & 15) * 4;
        *(f32x4*)(Kc + j * 64 + q4) = __builtin_nontemporal_load((const f32x4*)(ckb + j * 128 + q4));
        *(f32x4*)(Vc + j * 64 + q4) = __builtin_nontemporal_load((const f32x4*)(cvb + j * 128 + q4));
    }
    if (tid < 256) {
        const float qraw = bf2f(proj[pj(r, C_QA + kvh * 256 + tid)]);
        float ss = qraw * qraw;
#pragma unroll
        for (int o = 32; o >= 1; o >>= 1) ss += __shfl_xor(ss, o);
        lq[tid] = qraw * rsqrtf(ss * (1.f / 64.f) + EPS) * P.gq[lane] * 0.125f;
    } else if (tid < 320) {
        const float kraw = bf2f(proj[pj(r, C_KA + kvh * 64 + lane)]);
        float s2 = kraw * kraw;
#pragma unroll
        for (int o = 32; o >= 1; o >>= 1) s2 += __shfl_xor(s2, o);
        Kc[128 * 64 + lane] = kraw * rsqrtf(s2 * (1.f / 64.f) + EPS) * P.gk[lane];
        Vc[128 * 64 + lane] = bf2f(proj[pj(r, C_VA + kvh * 64 + lane)]);
    }
    __syncthreads();
    {
        float* okb = P.out + OUT_SK + (size_t)b * 16384 + kvh * 64; float* ovb = P.out + OUT_SV + (size_t)b * 16384 + kvh * 64;
#pragma unroll
        for (int i = 0; i < 4; ++i) {
            const int id = tid + 512 * i, j = id >> 4, q4 = (id & 15) * 4;
            __builtin_nontemporal_store(*(const f32x4*)(Kc + (j + 1) * 64 + q4), (f32x4*)(okb + j * 128 + q4));
            __builtin_nontemporal_store(*(const f32x4*)(Vc + (j + 1) * 64 + q4), (f32x4*)(ovb + j * 128 + q4));
        }
    }
    for (int idx = tid; idx < 4 * 129; idx += 512) {
        const int head = idx / 129, j = idx - head * 129;
        float s = 0.f;
#pragma unroll 8
        for (int d = 0; d < 64; ++d) { const int dd = (d + lane) & 63; s += Kc[j * 64 + dd] * lq[head * 64 + dd]; }
        lp[head * 132 + j] = s;
    }
    __syncthreads();
    if (wid < 4) {
        const int head = wid; const float sink = P.sinks[kvh * 4 + head];
        const float s0 = lp[head * 132 + lane], s1 = lp[head * 132 + 64 + lane], s2 = (lane == 0) ? lp[head * 132 + 128] : -INFINITY;
        float mx = fmaxf(fmaxf(s0, s1), fmaxf(s2, sink));
#pragma unroll
        for (int o = 32; o >= 1; o >>= 1) mx = fmaxf(mx, __shfl_xor(mx, o));
        const float p0 = __expf(s0 - mx), p1 = __expf(s1 - mx), p2 = (lane == 0) ? __expf(s2 - mx) : 0.f;
        float sum = p0 + p1 + p2;
#pragma unroll
        for (int o = 32; o >= 1; o >>= 1) sum += __shfl_xor(sum, o);
        const float inv = 1.f / (sum + __expf(sink - mx));
        lp[head * 132 + lane] = p0 * inv; lp[head * 132 + 64 + lane] = p1 * inv; if (lane == 0) lp[head * 132 + 128] = p2 * inv;
    }
    __syncthreads();
    if (wid < 4) {
        const int head = wid; float o = 0.f;
#pragma unroll 4
        for (int j = 0; j < 129; ++j) o += lp[head * 132 + j] * Vc[j * 64 + lane];
        ((bf16_t*)(P.ws + O_YMIX))[tm_off(r, 512 + (kvh * 4 + head) * 64 + lane, DM)] = (bf16_t)f2bf(o);
    }
    __syncthreads();
}

constexpr int NPHASE = 10;
#ifndef PHMASK
#define PHMASK 0x3ff
#endif
#define PHEN(p) ((PHMASK >> (p)) & 1)
#ifndef ITMASK
#define ITMASK 0xf
#endif
#define ITEN(p) ((ITMASK >> (p)) & 1)
#ifndef RPTITMASK
#define RPTITMASK 0xf
#endif
#define RPTIT(p) ((RPTITMASK >> (p)) & 1)
#ifndef RPTVAR
#define RPTVAR 0
#endif
template <bool LAST> DI void sample_strip_gemm(const Params& P, unsigned char* smem, const bf16_t* A, const bf16_t* Bt, int K, float scale) {
    const int lane = threadIdx.x & 63, wid = threadIdx.x >> 6, fr = lane & 15, fq = lane >> 4;
    const int rt = wid & 1, kq = wid >> 1;
    f32x4* red = (f32x4*)smem;
    const int nks = K / 128;
    for (int u = blockIdx.x; u < 256; u += gridDim.x) {
        const int cgp = u & 63, rg = u >> 6;
        const size_t rbase = (size_t)TP + 32 * rg + 16 * rt;
        const bf16_t* ap = A + tm_off(rbase + fr, 0, K) + 8 * fq;
        const bf16_t* bp = Bt + tm_off((size_t)16 * cgp + fr, 0, K) + 8 * fq;
        f32x4 acc0 = {0.f, 0.f, 0.f, 0.f}, acc1 = {0.f, 0.f, 0.f, 0.f};
#pragma unroll 6
        for (int ks = kq * nks; ks < (kq + 1) * nks; ks += 2) {
            const size_t o = (size_t)(ks >> 1) * 16384;
            const bf16x8 a0 = *(const bf16x8*)(ap + o), b0 = *(const bf16x8*)(bp + o);
            const bf16x8 a1 = *(const bf16x8*)(ap + o + 32), b1 = *(const bf16x8*)(bp + o + 32);
            acc0 = MFMA16(a0, b0, acc0); acc1 = MFMA16(a1, b1, acc1);
        }
        red[wid * 64 + lane] = acc0 + acc1;
        __syncthreads();
        if (wid < 2) {
            const f32x4 t = red[(0 + rt) * 64 + lane] + red[(2 + rt) * 64 + lane] + red[(4 + rt) * 64 + lane] + red[(6 + rt) * 64 + lane];
            bf16_t* xb = (bf16_t*)(P.ws + O_XB);
#pragma unroll
            for (int r = 0; r < 4; ++r) {
                const size_t row = rbase + 4 * fq + r; const int col = 16 * cgp + fr;
                float* op = P.out + row * DM + col;
                const float v = *op + scale * t[r];
                *op = v;
                if (!LAST) xb[tm_off(row, col, DM)] = (bf16_t)f2bf(v);
            }
        }
        __syncthreads();
    }
}

#define XB_TMO      128
#define XB_XCNT(j)  (256  + 64 * (j))
#define XB_XSUB(j)  (1280 + 64 * (j))
#define XB_XGEN(j)  (2304 + 64 * (j))
#define XB_TOP      3328
#define XB_TOPGEN   3392
#define XCD_BAR_WORDS 3456
#define XB_SPIN_CAP (1u << 18)
DI unsigned xb_ld(unsigned* p)              { return __hip_atomic_load(p, __ATOMIC_RELAXED, __HIP_MEMORY_SCOPE_AGENT); }
DI unsigned xb_add(unsigned* p, unsigned v) { return __hip_atomic_fetch_add(p, v, __ATOMIC_RELAXED, __HIP_MEMORY_SCOPE_AGENT); }
DI unsigned xb_xcc_id() { return (unsigned)__builtin_amdgcn_s_getreg((3 << 11) | 20) & 0xFu; }
#define XB_SPIN(cond, bar) do { unsigned _sp = 0; while (cond) { __builtin_amdgcn_s_sleep(1); \
    if ((++_sp & 255u) == 0u) { if (xb_ld(&(bar)[XB_TMO])) break; if (_sp > XB_SPIN_CAP) { atomicAdd(&(bar)[XB_TMO], 1u); break; } } } } while (0)
struct XcdBarrier { unsigned* bar; unsigned x; volatile LAS unsigned* st; };
DI XcdBarrier xcd_barrier_post(unsigned* bar, volatile LAS unsigned* st) {
    XcdBarrier b; b.bar = bar; b.x = xb_xcc_id(); b.st = st;
    if (threadIdx.x == 0) (void)xb_add(&bar[XB_XCNT(b.x)], 1u);
    return b;
}
DI void xcd_barrier_complete(unsigned* bar, unsigned x, unsigned& nloc, unsigned& nx) {
    const unsigned G = gridDim.x * gridDim.y * gridDim.z;
    unsigned sum, cnt, mine, sp = 0u;
    for (;;) {
        sum = 0u; cnt = 0u; mine = 0u;
#pragma unroll
        for (unsigned j = 0; j < 16; ++j) { const unsigned c = xb_ld(&bar[XB_XCNT(j)]); sum += c; cnt += (c > 0u) ? 1u : 0u; mine = (j == x) ? c : mine; }
        if (sum == G) break;
        __builtin_amdgcn_s_sleep(1);
        if ((++sp & 255u) == 0u) { if (xb_ld(&bar[XB_TMO])) break; if (sp > XB_SPIN_CAP) { atomicAdd(&bar[XB_TMO], 1u); break; } }
    }
    nloc = mine > 0u ? mine : 1u; nx = cnt > 0u ? cnt : 1u;
}
DI void xcd_barrier(const XcdBarrier& b) {
    asm volatile("s_waitcnt vmcnt(0)" ::: "memory");
    __syncthreads();
    if (threadIdx.x == 0) {
        unsigned* bar = b.bar;
        __builtin_amdgcn_s_waitcnt(0);
        unsigned nloc = b.st[0], nx = b.st[1];
        if (nloc == 0u) { xcd_barrier_complete(bar, b.x, nloc, nx); b.st[0] = nloc; b.st[1] = nx; }
        const unsigned old = xb_add(&bar[XB_XSUB(b.x)], 1u);
        const unsigned gen = old / nloc;
        if (old + 1u == (gen + 1u) * nloc) {
            __builtin_amdgcn_fence(__ATOMIC_RELEASE, "agent");
            asm volatile("s_waitcnt vmcnt(0)" ::: "memory");
            const unsigned og = xb_add(&bar[XB_TOP], 1u);
            const unsigned tg = og / nx;
            if (og + 1u == (tg + 1u) * nx) xb_add(&bar[XB_TOPGEN], 1u);
            else XB_SPIN(xb_ld(&bar[XB_TOPGEN]) == tg, bar);
            __builtin_amdgcn_fence(__ATOMIC_ACQUIRE, "agent");
            xb_add(&bar[XB_XGEN(b.x)], 1u);
            asm volatile("s_waitcnt vmcnt(0)" ::: "memory");
        } else {
            XB_SPIN(xb_ld(&bar[XB_XGEN(b.x)]) == gen, bar);
            __builtin_amdgcn_fence(__ATOMIC_ACQUIRE, "agent");
            asm volatile("s_waitcnt vmcnt(0)" ::: "memory");
        }
    }
    __syncthreads();
}

constexpr size_t O_PRIV = WS_TOTAL;
constexpr size_t WS_TOTAL2 = O_PRIV + (size_t)256 * 256 * DM * 2 / 8;
constexpr size_t O_BAR = WS_TOTAL2;
constexpr size_t WS_TOTAL3 = O_BAR + AL(XCD_BAR_WORDS * 4);
static_assert(WS_TOTAL3 <= (size_t)256 * 1024 * 1024, "workspace too large");
template <int K, bool RPT = false> DI void run_phase(const Params& P, unsigned char* smem) {
    LAS unsigned char* lds = (LAS unsigned char*)smem;
    pg8::MixOrder S;
    const int G = gridDim.x, c = blockIdx.x;
    bf16_t* xb = (bf16_t*)(P.ws + O_XB); bf16_t* big = (bf16_t*)(P.ws + O_BIG); float* ssq = (float*)(P.ws + O_SSQ);
    if constexpr (K == 0) phase0(P, smem);
    if constexpr (K == 1) {
        pg8::Gemm g{xb, xb + (size_t)TP * DM, (const bf16_t*)(P.ws + O_WGU1), DM};
        S.init(2 * FF, DM, G, c, G - 22 > 0 ? G - 22 : 0, 22, 1, 0);
        prep_rstd(smem, ssq, 1, S, nullptr);
        EpiSwiGLU E{big, (const LAS float*)(lds + RSL_OFF)};
        pg8::gemm_phase(lds, g, S, E);
        if (!RPT && G == 256 && c >= 128 && c < 234) {
            for (int j = c - 128; j < 528; j += 106) convert_weight_unit(P, (float*)smem, j < 352 ? 352 + j : 768 + (j - 352));
        }
    }
    if constexpr (K == 8) {
        pg8::Gemm g{xb, xb + (size_t)TP * DM, (const bf16_t*)(P.ws + O_WGU2), DM};
        S.init(2 * FF, DM, G, c, G - 22 > 0 ? G - 22 : 0, 22, 1, 0);
        prep_rstd(smem, ssq, 16, S, xb);
        EpiSwiGLU E{big, (const LAS float*)(lds + RSL_OFF)};
        pg8::gemm_phase(lds, g, S, E);
        if (!RPT && G == 256 && c >= 128 && c < 234) {
            for (int j = c - 128; j < 176; j += 106) convert_weight_unit(P, (float*)smem, 1120 + j);
        }
    }
    if constexpr (K == 2) {
        if (!RPT) sample_strip_gemm<false>(P, smem, big, (const bf16_t*)(P.ws + O_WD1), FF, 0.5f);
        pg8::Gemm g{big, big + (size_t)TP * FF, (const bf16_t*)(P.ws + O_WD1), FF};
        S.init(DM, FF, G, c, 0, 0, 2, 4);
        EpiResid<false> E{P.out, RPT ? 0.f : 0.5f, xb, ssq};
        pg8::gemm_phase(lds, g, S, E);
    }
    if constexpr (K == 3) {
        pg8::Gemm g{xb, xb + (size_t)TP * DM, (const bf16_t*)(P.ws + O_WIN), DM};
        S.init(PW, DM, G, c, G - 11 > 0 ? G - 11 : 0, 11, 1, 0);
        prep_rstd(smem, ssq, 16, S, xb);
        EpiRowScale E{big, PW, (const LAS float*)(lds + RSL_OFF)};
        pg8::gemm_phase(lds, g, S, E);
        if (!RPT && G == 256 && c >= 192 && c < 245) {
            for (int j = c - 192; j < 240; j += 53) convert_weight_unit(P, (float*)smem, j < 64 ? 704 + j : 944 + (j - 64));
        }
        gates_pass(P, smem);
    }
    if constexpr (K == 4) {
        const int nk = (1536 + (int)gridDim.x - 1) / (int)gridDim.x, rot = ((int)blockIdx.x % 3) * 2;
        for (int kk = 0; kk < nk; ++kk) {
            const int k = (kk + rot) % nk; const int it = blockIdx.x + k * gridDim.x;
            if (it >= 1536) continue;
            Params Q = P;
            asm volatile("" : "+s"(Q.ws), "+s"(Q.out));
            if (it < 512) { if (!RPT) m1_item<0>(Q, smem, it); else if (RPTIT(0)) m1_item<RPTVAR>(Q, smem, it); }
            else if (it < 768) { if (!RPT) swa_item<0>(Q, smem, it - 512); else if (RPTIT(1)) swa_item<RPTVAR>(Q, smem, it - 512); }
            else if (it < 1280) { if (!RPT || RPTIT(2)) smlstm_item(Q, smem, it - 768); }
            else { if (!RPT || RPTIT(3)) sswa_item(Q, smem, it - 1280); }
        }
    }
    if constexpr (K == 5) scan_phase(P, smem);
    if constexpr (K == 6) { for (int it = blockIdx.x; it < 512; it += gridDim.x) { if (!RPT) m3_item<0>(P, smem, it); else m3_item<RPTVAR>(P, smem, it); } }
    if constexpr (K == 7) {
        bf16_t* ym = (bf16_t*)(P.ws + O_YMIX);
        if (!RPT) sample_strip_gemm<false>(P, smem, ym, (const bf16_t*)(P.ws + O_WOUT), DM, 1.0f);
        pg8::Gemm g{ym, ym + (size_t)TP * DM, (const bf16_t*)(P.ws + O_WOUT), DM};
        S.init(DM, DM, G, c, 0, 0, 2, 4);
        EpiResid<false> E{P.out, RPT ? 0.f : 1.0f, xb, ssq};
        pg8::gemm_phase(lds, g, S, E);
    }
    if constexpr (K == 9) {
        if (!RPT) sample_strip_gemm<true>(P, smem, big, (const bf16_t*)(P.ws + O_WD2), FF, 0.5f);
        pg8::Gemm g{big, big + (size_t)TP * FF, (const bf16_t*)(P.ws + O_WD2), FF};
        S.init(DM, FF, G, c, 0, 0, 2, 4);
        EpiResid<true> E{P.out, RPT ? 0.f : 0.5f, xb, nullptr};
        pg8::gemm_phase(lds, g, S, E);
    }
}
#ifndef REPMASK
#define REPMASK 0
#endif
#define REP(k) ((REPMASK >> (k)) & 1)
__global__ void __launch_bounds__(512) hymba_megakernel(Params P, int ph_lo, int ph_hi) {
    extern __shared__ __attribute__((aligned(16))) unsigned char smem[];
    cg::grid_group grid = cg::this_grid();
    if (ph_lo < 0) grid.sync();
    volatile LAS unsigned* st = (volatile LAS unsigned*)((LAS unsigned char*)smem + (LDS_BYTES - 16));
    if (threadIdx.x == 0) { st[0] = 0u; st[1] = 0u; }
    __syncthreads();
    const XcdBarrier xb = xcd_barrier_post((unsigned*)(P.ws + O_BAR), st);
#define GSYNC() xcd_barrier(xb)
#define DOPH(k) do { if (PHEN(k) && ph_lo <= (k) && (k) < ph_hi) { if (REP(k)) { run_phase<k, true>(P, smem); GSYNC(); } run_phase<k>(P, smem); } \
                     if (ph_lo <= (k) && (k) + 1 < ph_hi) GSYNC(); } while (0)
#ifdef EXTRA_SYNC
    for (int i = 0; i < EXTRA_SYNC; ++i) GSYNC();
#endif
    DOPH(0); DOPH(1); DOPH(2); DOPH(3); DOPH(4); DOPH(5); DOPH(6); DOPH(7); DOPH(8); DOPH(9);
}

#ifndef MK_MULTI
#define MK_MULTI 0
#endif

extern "C" void kernel_launch(void* const* d_in, const int* in_sizes, int n_in, void* d_out, int out_size, void* d_ws, size_t ws_size, hipStream_t stream) {
    (void)in_sizes; (void)n_in; (void)out_size;
    static int grid_blocks = 0;
    if (!grid_blocks) {
        int dev = 0, cus = 0, per_cu = 0;
        hipGetDevice(&dev);
        hipDeviceGetAttribute(&cus, hipDeviceAttributeMultiprocessorCount, dev);
        hipFuncSetAttribute((const void*)hymba_megakernel, hipFuncAttributeMaxDynamicSharedMemorySize, LDS_BYTES);
        hipOccupancyMaxActiveBlocksPerMultiprocessor(&per_cu, hymba_megakernel, 512, LDS_BYTES);
        if (per_cu < 1) per_cu = 1;
        if (per_cu > 1) per_cu = 1;
        grid_blocks = cus * per_cu;
    }
    if (ws_size < WS_TOTAL3) { fprintf(stderr, "workspace too small: %zu < %zu\n", ws_size, (size_t)WS_TOTAL3); return; }
    Params p{};
    const float* const* in = (const float* const*)d_in;
    p.xp = in[0]; p.xs = in[1]; p.ck = in[2]; p.cv = in[3]; p.sC = in[4]; p.sn = in[5]; p.sm = in[6];
    p.g1 = in[7]; p.wg1 = in[8]; p.wu1 = in[9]; p.wd1 = in[10]; p.gmix = in[11]; p.win = in[12]; p.bi = in[13]; p.bfg = in[14];
    p.gout = in[15]; p.gq = in[16]; p.gk = in[17]; p.sinks = in[18]; p.wout = in[19]; p.g2 = in[20]; p.wg2 = in[21]; p.wu2 = in[22]; p.wd2 = in[23];
    p.out = (float*)d_out; p.ws = (unsigned char*)d_ws;
#if MK_MULTI
    for (int ph = 0; ph < NPHASE; ++ph) hipLaunchKernelGGL(hymba_megakernel, dim3(grid_blocks), dim3(512), LDS_BYTES, stream, p, ph, ph + 1);
#else
    hipMemsetAsync((unsigned char*)d_ws + O_BAR, 0, XCD_BAR_WORDS * 4, stream);
    int lo = 0, hi = NPHASE;
    void* args[] = {&p, &lo, &hi};
    hipError_t e = hipLaunchCooperativeKernel((const void*)hymba_megakernel, dim3(grid_blocks), dim3(512), args, LDS_BYTES, stream);
    if (e != hipSuccess) fprintf(stderr, "cooperative launch failed: %s (grid %d)\n", hipGetErrorString(e), grid_blocks);
#endif
}
```

```cpp
#include <hip/hip_runtime.h>
#include <hip/hip_cooperative_groups.h>
#include <cstdio>
namespace cg = cooperative_groups;

#define LAS __attribute__((address_space(3)))
typedef unsigned short bf16_t;
typedef short bf16x8 __attribute__((ext_vector_type(8)));
typedef short bf16x4 __attribute__((ext_vector_type(4)));
typedef float f32x4 __attribute__((ext_vector_type(4)));
typedef float f32x2 __attribute__((ext_vector_type(2)));
typedef __bf16 bfv2 __attribute__((ext_vector_type(2)));
typedef unsigned u32x4 __attribute__((ext_vector_type(4)));
typedef unsigned u32x2 __attribute__((ext_vector_type(2)));

#define DI __device__ __forceinline__

constexpr int TP = 16384, TS = 128, MV = TP + TS, MP = 16640;
constexpr int DM = 1024, FF = 2816, PW = 2816, WIN_LD = 2824;
constexpr float KSCALE = 0.08838834764831845f;
constexpr float EPS = 1e-6f;
constexpr int LDS_BYTES = 147456;

constexpr size_t AL(size_t x) { return (x + 255) & ~(size_t)255; }
constexpr size_t O_WGU1 = 0;
constexpr size_t O_WD1  = O_WGU1 + AL((size_t)2 * FF * DM * 2);
constexpr size_t O_WIN  = O_WD1 + AL((size_t)DM * FF * 2);
constexpr size_t O_WOUT = O_WIN + AL((size_t)PW * DM * 2);
constexpr size_t O_WGU2 = O_WOUT + AL((size_t)DM * DM * 2);
constexpr size_t O_WD2  = O_WGU2 + AL((size_t)2 * FF * DM * 2);
constexpr size_t O_XB   = O_WD2 + AL((size_t)DM * FF * 2);
constexpr size_t O_BIG  = O_XB + AL((size_t)MP * DM * 2);
constexpr size_t O_YMIX = O_BIG + AL((size_t)MP * FF * 2);
constexpr size_t O_CST  = O_YMIX + AL((size_t)MP * DM * 2);
constexpr size_t O_SSQ  = O_CST + AL((size_t)512 * 16384 * 2);
constexpr size_t O_GATE = O_SSQ + AL((size_t)16 * MP * 4);
constexpr size_t O_DN   = O_GATE + AL((size_t)MP * 8 * 4);
constexpr size_t O_NST  = O_DN + AL((size_t)512 * 128 * 4);
constexpr size_t O_ML   = O_NST + AL((size_t)512 * 128 * 4);
constexpr size_t O_BL   = O_ML + AL(512 * 4);
constexpr size_t O_MST  = O_BL + AL(512 * 4);
constexpr size_t WS_TOTAL = O_MST + AL(512 * 4);
static_assert(WS_TOTAL <= (size_t)256 * 1024 * 1024, "workspace too large");
static_assert((size_t)512 * 16384 * 4 <= (size_t)MP * DM * 2, "dC alias");

constexpr size_t OUT_Y = 0;
constexpr size_t OUT_PK = (size_t)MV * DM;
constexpr size_t OUT_PV = OUT_PK + 65536;
constexpr size_t OUT_PC = OUT_PV + 65536;
constexpr size_t OUT_PN = OUT_PC + 262144;
constexpr size_t OUT_PM = OUT_PN + 2048;
constexpr size_t OUT_SK = OUT_PM + 16;
constexpr size_t OUT_SV = OUT_SK + 2097152;
constexpr size_t OUT_SC = OUT_SV + 2097152;
constexpr size_t OUT_SN = OUT_SC + 8388608;
constexpr size_t OUT_SM = OUT_SN + 65536;

struct Params {
    const float *xp, *xs, *ck, *cv, *sC, *sn, *sm;
    const float *g1, *wg1, *wu1, *wd1, *gmix, *win, *bi, *bfg, *gout, *gq, *gk, *sinks, *wout, *g2, *wg2, *wu2, *wd2;
    float* out;
    unsigned char* ws;
};

DI size_t tm_off(size_t row, int col, int K) { return ((row >> 8) * (size_t)(K >> 6) + (size_t)(col >> 6)) * 16384 + (row & 255) * 64 + (col & 63); }
DI size_t pj(size_t row, int col);
DI unsigned pk_bf16(float a, float b) { f32x2 v = {a, b}; bfv2 r = __builtin_convertvector(v, bfv2); return __builtin_bit_cast(unsigned, r); }
DI float bf2f(short b) { return __uint_as_float(((unsigned)(unsigned short)b) << 16); }
DI short f2bf(float a) { return (short)(pk_bf16(a, 0.f) & 0xffffu); }
DI bf16x8 pack8(const float* f) { u32x4 p; p[0] = pk_bf16(f[0], f[1]); p[1] = pk_bf16(f[2], f[3]); p[2] = pk_bf16(f[4], f[5]); p[3] = pk_bf16(f[6], f[7]); return __builtin_bit_cast(bf16x8, p); }
DI float sigmoidf_(float x) { return 1.f / (1.f + __expf(-x)); }
#define MFMA16(a, b, c) __builtin_amdgcn_mfma_f32_16x16x32_bf16((a), (b), (c), 0, 0, 0)

namespace pg8 {
constexpr int BM = 256, BK = 64, HALF = 128, HTB = HALF * BK * 2, STAGE_BYTES = 8 * HTB, NXCD = 8, WGM = 8;
DI int lds_byte(int r, int c) { const int st = (r >> 4) * 2 + (c >> 5), rr = r & 15, cc = c & 31, ob = rr * 64 + cc * 2; return st * 1024 + (ob ^ (((ob >> 9) & 1) << 5)); }
DI void stage_rc(int b, int& R, int& C) { const int st = b / 1024, sb = b % 1024, swz = sb ^ (((sb >> 9) & 1) << 5); R = (st >> 1) * 16 + swz / 64; C = (st & 1) * 32 + (swz % 64) / 2; }
DI int perm32(int rho) { const int n = rho >> 4, i = rho & 15; return 8 * (i >> 2) + 4 * n + (i & 3); }
struct Unit { int pm, pn, ui, kt0, nt, kind; };
struct Gemm { const bf16_t* A; const bf16_t* A2; const bf16_t* Bt; int K; };
struct MixOrder {
    int nN, nwg, G, c, ntFull, sLo, sCnt, sKind, sNt;
    DI void init(int N, int K, int G_, int c_, int sLo_, int sCnt_, int sKind_, int sNt_) { nN = N / BM; nwg = 64 * nN; G = G_; c = c_; ntFull = K / BK; sLo = sLo_; sCnt = sCnt_; sKind = sKind_; sNt = sNt_; }
    DI bool next(int i, Unit& u) const {
        const bool hasS = (c >= sLo) && (c < sLo + sCnt);
        const bool isS = hasS && (i == 0);
        const int ii = hasS ? i - 1 : i;
        const long L = (long)ii * G + c;
        if (!isS && L >= nwg) return false;
        int wgid = isS ? 0 : (int)L; { const int q = nwg / NXCD, r = nwg % NXCD, xcd = wgid % NXCD, off = wgid / NXCD; wgid = (xcd < r ? xcd * (q + 1) : r * (q + 1) + (xcd - r) * q) + off; }
        const int nig = WGM * nN, gid = wgid / nig, fm = gid * WGM;
        const int ppm = fm + ((wgid % nig) % WGM), ppn = (wgid % nig) / WGM;
        const int idx = c - sLo;
        const int spn = (sKind == 1) ? idx : idx % nN, skt0 = (sKind == 1) ? 0 : (idx / nN) * sNt, snt = (sKind == 1) ? ntFull : sNt;
        Unit r;
        r.pm = isS ? 64 : ppm; r.pn = isS ? spn : ppn; r.ui = i; r.kt0 = isS ? skt0 : 0; r.nt = isS ? snt : ntFull; r.kind = isS ? sKind : 0;
        u = r;
        return true;
    }
    DI void a_ready(const Unit&) const {}
    DI void done(const Unit&) const {}
};

template <class Epi, class Sched>
DI void gemm_phase(LAS unsigned char* lds, const Gemm g, const Sched& S, const Epi& E) {
    const int tid = threadIdx.x, wid = __builtin_amdgcn_readfirstlane(tid >> 6), lane = tid & 63, wr = wid >> 2, wc = wid & 3, fr = lane & 15, fq = lane >> 4;
    const int K = g.K;
    unsigned voffA[2], voffB[2];
#pragma unroll
    for (int i = 0; i < 2; ++i) { int R, C; stage_rc(tid * 16 + i * 8192, R, C); const int Rb = Epi::PERM ? ((R & ~31) + perm32(R & 31)) : R;
        voffA[i] = (unsigned)(R * 64 + C) * 2u; voffB[i] = (unsigned)(Rb * 64 + C) * 2u; }
    const size_t kstep = (size_t)32768;
    const size_t hstep = (size_t)16384;
    const size_t tstep = (size_t)(K / BK) * kstep;
    const unsigned ldsw = (unsigned)wid * 1024u;
    const int aoff = lds_byte(wr * 64 + fr, fq * 8), boff = lds_byte(wc * 32 + fr, fq * 8);
#define PG8_SA(b, h) (((b) * 2 + (h)) * HTB)
#define PG8_SB(b, h) ((4 + (b) * 2 + (h)) * HTB)
#define PG8_STAGE(bufoff, gbase, voff) do { _Pragma("unroll") for (int _i = 0; _i < 2; ++_i) \
        __builtin_amdgcn_global_load_lds((const unsigned*)((const char*)(gbase) + (voff)[_i]), (LAS unsigned*)(lds + (bufoff) + ldsw + _i * 8192), 16, 0, 0); } while (0)
#define PG8_LDA(dst, b, h) do { _Pragma("unroll") for (int m = 0; m < 4; ++m) _Pragma("unroll") for (int k = 0; k < 2; ++k) dst[m][k] = *(const LAS bf16x8*)(lds + PG8_SA(b, h) + aoff + m * 2048 + k * 1024); } while (0)
#define PG8_LDB(dst, b, h) do { _Pragma("unroll") for (int n = 0; n < 2; ++n) _Pragma("unroll") for (int k = 0; k < 2; ++k) dst[n][k] = *(const LAS bf16x8*)(lds + PG8_SB(b, h) + boff + n * 2048 + k * 1024); } while (0)
#define PG8_MMA(ai, bj, At, Bt) do { __builtin_amdgcn_s_setprio(1); _Pragma("unroll") for (int m = 0; m < 4; ++m) _Pragma("unroll") for (int n = 0; n < 2; ++n) _Pragma("unroll") for (int k = 0; k < 2; ++k) \
        acc[ai][bj][m][n] = __builtin_amdgcn_mfma_f32_16x16x32_bf16(Bt[n][k], At[m][k], acc[ai][bj][m][n], 0, 0, 0); __builtin_amdgcn_s_setprio(0); } while (0)
#define PG8_WAIT_V(n) asm volatile("s_waitcnt vmcnt(" #n ")" ::: "memory")
#define PG8_WAIT_L(n) asm volatile("s_waitcnt lgkmcnt(" #n ")" ::: "memory")
#define PG8_BAR __builtin_amdgcn_s_barrier()
#define PG8_SCHED __builtin_amdgcn_sched_barrier(0)
    Unit cur, nxt; int ui = 0;
    if (!S.next(0, cur)) return;
    f32x4 acc[2][2][4][2];
#pragma unroll
    for (int a = 0; a < 2; ++a)
#pragma unroll
        for (int b = 0; b < 2; ++b)
#pragma unroll
            for (int m = 0; m < 4; ++m)
#pragma unroll
                for (int n = 0; n < 2; ++n) acc[a][b][m][n] = (f32x4){0.f, 0.f, 0.f, 0.f};
    bf16x8 At[4][2], B0[2][2], B1[2][2];
    const char* cA = (cur.kind ? (const char*)g.A2 : (const char*)g.A + (size_t)cur.pm * tstep) + (size_t)cur.kt0 * kstep; const char* cB = (const char*)g.Bt + (size_t)cur.pn * tstep + (size_t)cur.kt0 * kstep;
    S.a_ready(cur);
    PG8_STAGE(PG8_SB(0, 0), cB, voffB); PG8_STAGE(PG8_SA(0, 0), cA, voffA); PG8_STAGE(PG8_SB(0, 1), cB + hstep, voffB); PG8_STAGE(PG8_SA(0, 1), cA + hstep, voffA);
    if (wr == 1) PG8_BAR;
    PG8_WAIT_V(4); PG8_BAR;
    PG8_STAGE(PG8_SB(1, 0), cB + kstep, voffB); PG8_STAGE(PG8_SA(1, 0), cA + kstep, voffA); PG8_STAGE(PG8_SB(1, 1), cB + hstep + kstep, voffB);
    PG8_WAIT_V(6); PG8_BAR;
    for (;;) {
        const bool has_next = S.next(ui + 1, nxt);
        const char* nA = has_next ? (nxt.kind ? (const char*)g.A2 : (const char*)g.A + (size_t)nxt.pm * tstep) + (size_t)nxt.kt0 * kstep : cA; const char* nB = has_next ? (const char*)g.Bt + (size_t)nxt.pn * tstep + (size_t)nxt.kt0 * kstep : cB;
        const int nt = cur.nt;
        for (int t = 0; t < nt; t += 2) {
            const bool last = (t == nt - 2);
            const char* a1 = cA + (size_t)(t + 1) * kstep;
            const char* a2 = last ? nA : cA + (size_t)(t + 2) * kstep; const char* b2 = last ? nB : cB + (size_t)(t + 2) * kstep;
            const char* a3 = a2 + kstep; const char* b3 = b2 + kstep;
            if (last && has_next) S.a_ready(nxt);
            PG8_LDB(B0, 0, 0); PG8_SCHED; PG8_LDA(At, 0, 0); PG8_STAGE(PG8_SA(1, 1), a1 + hstep, voffA);
            PG8_WAIT_L(8); PG8_BAR; PG8_WAIT_L(0); PG8_MMA(0, 0, At, B0); PG8_BAR; PG8_SCHED;
            PG8_LDB(B1, 0, 1); PG8_STAGE(PG8_SB(0, 0), b2, voffB);
            PG8_BAR; PG8_WAIT_L(0); PG8_MMA(0, 1, At, B1); PG8_BAR;
            PG8_LDA(At, 0, 1); PG8_STAGE(PG8_SA(0, 0), a2, voffA);
            PG8_BAR; PG8_WAIT_L(0); PG8_MMA(1, 0, At, B0); PG8_BAR; PG8_SCHED;
            PG8_STAGE(PG8_SB(0, 1), b2 + hstep, voffB);
            PG8_WAIT_V(6); PG8_BAR; PG8_MMA(1, 1, At, B1); PG8_BAR;
            PG8_LDB(B0, 1, 0); PG8_SCHED; PG8_LDA(At, 1, 0); PG8_STAGE(PG8_SA(0, 1), a2 + hstep, voffA);
            PG8_WAIT_L(8); PG8_BAR; PG8_WAIT_L(0); PG8_MMA(0, 0, At, B0); PG8_BAR; PG8_SCHED;
            PG8_LDB(B1, 1, 1); PG8_STAGE(PG8_SB(1, 0), b3, voffB);
            PG8_BAR; PG8_WAIT_L(0); PG8_MMA(0, 1, At, B1); PG8_BAR;
            PG8_LDA(At, 1, 1); PG8_STAGE(PG8_SA(1, 0), a3, voffA);
            PG8_BAR; PG8_WAIT_L(0); PG8_MMA(1, 0, At, B0); PG8_BAR; PG8_SCHED;
            PG8_STAGE(PG8_SB(1, 1), b3 + hstep, voffB);
            PG8_WAIT_V(6); PG8_BAR; PG8_MMA(1, 1, At, B1); PG8_BAR;
        }
        E(acc, cur, wr, wc, fr, fq); S.done(cur);
        if (!has_next) break;
#pragma unroll
        for (int a = 0; a < 2; ++a)
#pragma unroll
            for (int b = 0; b < 2; ++b)
#pragma unroll
                for (int m = 0; m < 4; ++m)
#pragma unroll
                    for (int n = 0; n < 2; ++n) acc[a][b][m][n] = (f32x4){0.f, 0.f, 0.f, 0.f};
        cur = nxt; cA = nA; cB = nB; ++ui;
    }
    PG8_WAIT_V(0);
    if (wr == 0) PG8_BAR;
    PG8_BAR;
#undef PG8_SA
#undef PG8_SB
#undef PG8_STAGE
#undef PG8_LDA
#undef PG8_LDB
#undef PG8_MMA
#undef PG8_WAIT_V
#undef PG8_WAIT_L
#undef PG8_BAR
#undef PG8_SCHED
}
}
using pg8::Unit;

constexpr int RSL_OFF = 131072;
template <class Sched> DI void prep_rstd(unsigned char* smem, const float* __restrict__ ssq, int np, const Sched& S, const void* conv) {
    float* rsl = (float*)(smem + RSL_OFF);
    int* upm = (int*)(smem + RSL_OFF + 8 * 256 * 4);
    const int tid = threadIdx.x, lane = tid & 63, wid = tid >> 6;
    int nu = 0;
    {
        Unit u;
#pragma unroll 1
        for (int i = 0; i < 8 && S.next(i, u); ++i) {
            const bool cv = (u.kind == 1) && (conv != nullptr);
            if (tid == 0) upm[i] = cv ? -1 : u.pm;
            if (cv) {
                const bf16_t* xbs = (const bf16_t*)conv;
#pragma unroll 8
                for (int rr = 0; rr < 16; ++rr) {
                    const int r = rr * 8 + wid;
                    const bf16_t* src = xbs + tm_off((size_t)TP + r, 16 * lane, DM);
                    const bf16x8 v0 = *(const bf16x8*)src, v1 = *(const bf16x8*)(src + 8);
                    float ss = 0.f;
#pragma unroll
                    for (int e = 0; e < 8; ++e) { const float x0 = bf2f(v0[e]), x1 = bf2f(v1[e]); ss += x0 * x0 + x1 * x1; }
#pragma unroll
                    for (int o = 32; o >= 1; o >>= 1) ss += __shfl_xor(ss, o);
                    if (lane == 0) rsl[i * 256 + r] = rsqrtf(ss * (1.f / DM) + EPS);
                }
                if (tid < 128) rsl[i * 256 + 128 + tid] = 0.f;
            }
            nu = i + 1;
        }
    }
    __syncthreads();
    if (np == 16) {
        for (int idx = tid; idx < nu * 256; idx += 512) {
            const int i = idx >> 8, r = idx & 255, pm = upm[i];
            if (pm < 0) continue;
            const float* p = ssq + (size_t)pm * 256 + r;
            float v[16];
#pragma unroll
            for (int q = 0; q < 16; ++q) v[q] = p[(size_t)q * MP];
            float s = 0.f;
#pragma unroll
            for (int q = 0; q < 16; ++q) s += v[q];
            rsl[idx] = rsqrtf(s * (1.f / DM) + EPS);
        }
    } else {
        for (int idx = tid; idx < nu * 256; idx += 512) {
            const int i = idx >> 8, r = idx & 255, pm = upm[i];
            if (pm < 0) continue;
            rsl[idx] = rsqrtf(ssq[(size_t)pm * 256 + r] * (1.f / DM) + EPS);
        }
    }
    __syncthreads();
    asm volatile("" ::: "memory");
}
struct EpiSwiGLU {
    static constexpr bool PERM = true;
    bf16_t* act; const LAS float* rsl;
    DI void operator()(const f32x4 (&acc)[2][2][4][2], const Unit& u, int wr, int wc, int fr, int fq) const {
        const int row0 = u.pm * 256 + wr * 64 + fr, col0 = u.pn * 128 + wc * 32 + 8 * fq;
#pragma unroll
        for (int ai = 0; ai < 2; ++ai)
#pragma unroll
            for (int m = 0; m < 4; ++m) {
                const int row = row0 + ai * 128 + m * 16; const float rs = rsl[u.ui * 256 + wr * 64 + fr + ai * 128 + m * 16];
                float o[8];
#pragma unroll
                for (int n = 0; n < 2; ++n)
#pragma unroll
                    for (int i = 0; i < 4; ++i) { const float gv = acc[ai][0][m][n][i] * rs, uv = acc[ai][1][m][n][i] * rs; o[n * 4 + i] = gv * __builtin_amdgcn_rcpf(1.f + __expf(-gv)) * uv; }
                *(bf16x8*)(act + tm_off(row, col0, FF)) = pack8(o);
                asm volatile("" ::: "memory");
            }
    }
};
struct EpiRowScale {
    static constexpr bool PERM = true;
    bf16_t* O; int ldo; const LAS float* rsl;
    DI void operator()(const f32x4 (&acc)[2][2][4][2], const Unit& u, int wr, int wc, int fr, int fq) const {
        const int row0 = u.pm * 256 + wr * 64 + fr, col0 = u.pn * 256 + wc * 32 + 8 * fq;
#pragma unroll
        for (int ai = 0; ai < 2; ++ai)
#pragma unroll
            for (int m = 0; m < 4; ++m) {
                const int row = row0 + ai * 128 + m * 16; const float rs = rsl[u.ui * 256 + wr * 64 + fr + ai * 128 + m * 16];
#pragma unroll
                for (int bj = 0; bj < 2; ++bj) {
                    float o[8];
#pragma unroll
                    for (int n = 0; n < 2; ++n)
#pragma unroll
                        for (int i = 0; i < 4; ++i) o[n * 4 + i] = acc[ai][bj][m][n][i] * rs;
                    *(bf16x8*)(O + pj(row, col0 + bj * 128)) = pack8(o);
                }
                asm volatile("" ::: "memory");
            }
    }
};
template <bool LAST> struct EpiResid {
    static constexpr bool PERM = false;
    float* out; float scale; bf16_t* xb; float* ssqp;
    DI void operator()(const f32x4 (&acc)[2][2][4][2], const Unit& u, int wr, int wc, int fr, int fq) const {
        const int col0 = u.pn * 256 + wc * 32 + 4 * fq;
        if (u.kind == 2) {
#pragma unroll
            for (int m = 0; m < 4; ++m) {
                float* op = out + (size_t)(TP + wr * 64 + m * 16 + fr) * DM + col0;
#pragma unroll
                for (int bj = 0; bj < 2; ++bj)
#pragma unroll
                    for (int n = 0; n < 2; ++n)
#pragma unroll
                        for (int i = 0; i < 4; ++i) __hip_atomic_fetch_add(op + bj * 128 + n * 16 + i, scale * acc[0][bj][m][n][i], __ATOMIC_RELAXED, __HIP_MEMORY_SCOPE_AGENT);
                asm volatile("" ::: "memory");
            }
            return;
        }
        const int row0 = u.pm * 256 + wr * 64 + fr;
#pragma unroll
        for (int ai = 0; ai < 2; ++ai) {
            bf16x4 rb[4][2][2];
#pragma unroll
            for (int m = 0; m < 4; ++m)
#pragma unroll
                for (int bj = 0; bj < 2; ++bj)
#pragma unroll
                    for (int n = 0; n < 2; ++n) rb[m][bj][n] = *(const bf16x4*)(xb + tm_off(row0 + ai * 128 + m * 16, col0 + bj * 128 + n * 16, DM));
#pragma unroll
            for (int m = 0; m < 4; ++m) {
                const int row = row0 + ai * 128 + m * 16;
                float ss = 0.f;
#pragma unroll
                for (int bj = 0; bj < 2; ++bj)
#pragma unroll
                    for (int n = 0; n < 2; ++n) {
                        const int c = col0 + bj * 128 + n * 16;
                        bf16_t* xp4 = xb + tm_off(row, c, DM);
                        const bf16x4 r4 = rb[m][bj][n];
                        const f32x4 r = {bf2f(r4[0]), bf2f(r4[1]), bf2f(r4[2]), bf2f(r4[3])};
                        const f32x4 o = r + scale * acc[ai][bj][m][n];
                        if (LAST) *(f32x4*)(out + (size_t)row * DM + c) = o;
                        else { ss += o[0] * o[0] + o[1] * o[1] + o[2] * o[2] + o[3] * o[3];
                            u32x2 pk; pk[0] = pk_bf16(o[0], o[1]); pk[1] = pk_bf16(o[2], o[3]); *(u32x2*)xp4 = pk; }
                    }
                if (!LAST) { ss += __shfl_xor(ss, 16); ss += __shfl_xor(ss, 32); if (fq == 0) ssqp[(size_t)(u.pn * 4 + wc) * MP + row] = ss; }
            }
            asm volatile("" ::: "memory");
        }
    }
};

DI void convert_unit(float* tl, const float* __restrict__ W, int ldw, int k0, int srccol0, const float* __restrict__ gain, bf16_t* __restrict__ Wt, int ldk, int dstrow0) {
    const int tid = threadIdx.x;
    f32x4 v[8]; float g[8];
#pragma unroll
    for (int i = 0; i < 8; ++i) {
        const int kk = (tid >> 4) + 32 * i, c4 = (tid & 15) * 4;
        v[i] = *(const f32x4*)(W + (size_t)(k0 + kk) * ldw + srccol0 + c4);
        g[i] = gain ? gain[k0 + kk] : 1.f;
    }
#pragma unroll
    for (int i = 0; i < 8; ++i) {
        const int kk = (tid >> 4) + 32 * i, c4 = (tid & 15) * 4;
#pragma unroll
        for (int j = 0; j < 4; ++j) tl[kk * 65 + c4 + j] = v[i][j] * g[i];
    }
    __syncthreads();
#pragma unroll
    for (int i = 0; i < 4; ++i) {
        const int id = tid + 512 * i, n = id & 63, kc = (id >> 6) * 8; float f[8];
#pragma unroll
        for (int e = 0; e < 8; ++e) f[e] = tl[(kc + e) * 65 + n];
        *(bf16x8*)(Wt + tm_off(dstrow0 + n, k0 + kc, ldk)) = pack8(f);
    }
    __syncthreads();
}
DI void convert_weight_unit(const Params& P, float* tl, int id) {
    if (id < 352 || (id >= 768 && id < 1120)) {
        const bool second = id >= 768; if (second) id -= 768;
        const int ntile = id % 88, kt = id / 88, dstrow0 = ntile * 64, pn = dstrow0 >> 8, hh = (dstrow0 >> 7) & 1, j0 = dstrow0 & 127;
        const float* W = second ? (hh ? P.wu2 : P.wg2) : (hh ? P.wu1 : P.wg1);
        convert_unit(tl, W, FF, kt * 256, pn * 128 + j0, second ? P.g2 : P.g1, (bf16_t*)(P.ws + (second ? O_WGU2 : O_WGU1)), DM, dstrow0);
    } else if (id < 528 || id >= 1120) {
        const bool second = id >= 1120; id -= second ? 1120 : 352;
        const int ntile = id % 16, kt = id / 16;
        convert_unit(tl, second ? P.wd2 : P.wd1, DM, kt * 256, ntile * 64, nullptr, (bf16_t*)(P.ws + (second ? O_WD2 : O_WD1)), FF, ntile * 64);
    } else if (id < 704) {
        id -= 528; const int ntile = id % 44, kt = id / 44, dstrow0 = ntile * 64;
        convert_unit(tl, P.win, WIN_LD, kt * 256, dstrow0 < 2048 ? dstrow0 : dstrow0 + 8, P.gmix, (bf16_t*)(P.ws + O_WIN), DM, dstrow0);
    } else {
        id -= 704; const int ntile = id % 16, kt = id / 16;
        convert_unit(tl, P.wout, DM, kt * 256, ntile * 64, nullptr, (bf16_t*)(P.ws + O_WOUT), DM, ntile * 64);
    }
}
struct WDesc { const float* W; const float* gain; bf16_t* Wt; int ldw, k0, srccol0, ldk, dstrow0; };
DI WDesc wdesc(const Params& P, int id) {
    WDesc d;
    if (id < 352 || (id >= 768 && id < 1120)) {
        const bool second = id >= 768; if (second) id -= 768;
        const int ntile = id % 88, kt = id / 88, dstrow0 = ntile * 64, pn = dstrow0 >> 8, hh = (dstrow0 >> 7) & 1, j0 = dstrow0 & 127;
        d.W = second ? (hh ? P.wu2 : P.wg2) : (hh ? P.wu1 : P.wg1); d.gain = second ? P.g2 : P.g1; d.Wt = (bf16_t*)(P.ws + (second ? O_WGU2 : O_WGU1));
        d.ldw = FF; d.k0 = kt * 256; d.srccol0 = pn * 128 + j0; d.ldk = DM; d.dstrow0 = dstrow0;
    } else if (id < 528 || id >= 1120) {
        const bool second = id >= 1120; id -= second ? 1120 : 352;
        const int ntile = id % 16, kt = id / 16;
        d.W = second ? P.wd2 : P.wd1; d.gain = nullptr; d.Wt = (bf16_t*)(P.ws + (second ? O_WD2 : O_WD1)); d.ldw = DM; d.k0 = kt * 256; d.srccol0 = ntile * 64; d.ldk = FF; d.dstrow0 = ntile * 64;
    } else if (id < 704) {
        id -= 528; const int ntile = id % 44, kt = id / 44, dstrow0 = ntile * 64;
        d.W = P.win; d.gain = P.gmix; d.Wt = (bf16_t*)(P.ws + O_WIN); d.ldw = WIN_LD; d.k0 = kt * 256; d.srccol0 = dstrow0 < 2048 ? dstrow0 : dstrow0 + 8; d.ldk = DM; d.dstrow0 = dstrow0;
    } else {
        id -= 704; const int ntile = id % 16, kt = id / 16;
        d.W = P.wout; d.gain = nullptr; d.Wt = (bf16_t*)(P.ws + O_WOUT); d.ldw = DM; d.k0 = kt * 256; d.srccol0 = ntile * 64; d.ldk = DM; d.dstrow0 = ntile * 64;
    }
    return d;
}
DI void p0_load(const Params& P, int t, int nW, f32x4 (&v)[8], float (&g)[8]) {
    const int tid = threadIdx.x, lane = tid & 63, wid = tid >> 6;
    if (t < nW) {
        const WDesc d = wdesc(P, t);
#pragma unroll
        for (int i = 0; i < 8; ++i) {
            const int kk = (tid >> 4) + 32 * i, c4 = (tid & 15) * 4;
            v[i] = __builtin_nontemporal_load((const f32x4*)(d.W + (size_t)(d.k0 + kk) * d.ldw + d.srccol0 + c4));
            g[i] = d.gain ? d.gain[d.k0 + kk] : 1.f;
        }
    } else {
        const int id = t - nW;
#pragma unroll
        for (int rr = 0; rr < 2; ++rr) {
            const int row = id * 16 + rr * 8 + wid;
            const float* src = row < TP ? P.xp + (size_t)row * DM : P.xs + (size_t)(row - TP) * DM;
#pragma unroll
            for (int i = 0; i < 4; ++i) v[rr * 4 + i] = __builtin_nontemporal_load((const f32x4*)(src + i * 256 + lane * 4));
        }
    }
}
DI void p0_proc(const Params& P, float* tl, int t, int nW, const f32x4 (&v)[8], const float (&g)[8]) {
    const int tid = threadIdx.x, lane = tid & 63, wid = tid >> 6;
    if (t < nW) {
        const WDesc d = wdesc(P, t);
#pragma unroll
        for (int i = 0; i < 8; ++i) {
            const int kk = (tid >> 4) + 32 * i, c4 = (tid & 15) * 4;
#pragma unroll
            for (int j = 0; j < 4; ++j) tl[kk * 65 + c4 + j] = v[i][j] * g[i];
        }
        __syncthreads();
#pragma unroll
        for (int i = 0; i < 4; ++i) {
            const int id = tid + 512 * i, n = id & 63, kc = (id >> 6) * 8; float f[8];
#pragma unroll
            for (int e = 0; e < 8; ++e) f[e] = tl[(kc + e) * 65 + n];
            *(bf16x8*)(d.Wt + tm_off(d.dstrow0 + n, d.k0 + kc, d.ldk)) = pack8(f);
        }
        __syncthreads();
    } else {
        bf16_t* xb = (bf16_t*)(P.ws + O_XB); float* ssq = (float*)(P.ws + O_SSQ);
        const int id = t - nW;
#pragma unroll
        for (int rr = 0; rr < 2; ++rr) {
            const int row = id * 16 + rr * 8 + wid;
            float ss = 0.f;
#pragma unroll
            for (int i = 0; i < 4; ++i) {
                const f32x4 x = v[rr * 4 + i];
                ss += x[0] * x[0] + x[1] * x[1] + x[2] * x[2] + x[3] * x[3];
                u32x2 pk; pk[0] = pk_bf16(x[0], x[1]); pk[1] = pk_bf16(x[2], x[3]);
                *(u32x2*)(xb + tm_off(row, i * 256 + lane * 4, DM)) = pk;
                if (row >= TP) *(f32x4*)(P.out + (size_t)row * DM + i * 256 + lane * 4) = x;
            }
#pragma unroll
            for (int o = 32; o >= 1; o >>= 1) ss += __shfl_xor(ss, o);
            if (lane == 0) ssq[row] = ss;
        }
    }
}
DI void phase0(const Params& P, unsigned char* smem) {
    float* tl = (float*)smem;
    const int nW = (gridDim.x == 256) ? 352 : 1296, N = nW + 1032, G = gridDim.x;
    f32x4 va[8], vb[8]; float ga[8], gb[8];
    int t = blockIdx.x;
    if (t < N) p0_load(P, t, nW, va, ga);
    while (t < N) {
        int t2 = t + G;
        if (t2 < N) p0_load(P, t2, nW, vb, gb);
        p0_proc(P, tl, t, nW, va, ga);
        t = t2; if (t >= N) break;
        t2 = t + G;
        if (t2 < N) p0_load(P, t2, nW, va, ga);
        p0_proc(P, tl, t, nW, vb, gb);
        t = t2;
    }
}

template <class F> DI void convert_list(const Params& P, float* tl, int j0, int n, int step, F idmap) {
    constexpr int ALLW = 1 << 30;
    f32x4 va[8], vb[8]; float ga[8], gb[8];
    int j = j0;
    if (j < n) p0_load(P, idmap(j), ALLW, va, ga);
    while (j < n) {
        int j2 = j + step;
        if (j2 < n) p0_load(P, idmap(j2), ALLW, vb, gb);
        p0_proc(P, tl, idmap(j), ALLW, va, ga);
        j = j2; if (j >= n) break;
        j2 = j + step;
        if (j2 < n) p0_load(P, idmap(j2), ALLW, va, ga);
        p0_proc(P, tl, idmap(j), ALLW, vb, gb);
        j = j2;
    }
}

DI void gates_pass(const Params& P, unsigned char* smem) {
    bf16_t* wg = (bf16_t*)smem;
    float* lss = (float*)(smem + 16 * 1032 * 2);
    const int tid = threadIdx.x, lane = tid & 63, wid = tid >> 6, fr = lane & 15, fq = lane >> 4;
#pragma unroll
    for (int j = 0; j < 2; ++j) {
        const int k = tid + 512 * j; const float g = P.gmix[k];
        const f32x4 v0 = *(const f32x4*)(P.win + (size_t)k * WIN_LD + 2048), v1 = *(const f32x4*)(P.win + (size_t)k * WIN_LD + 2052);
#pragma unroll
        for (int n = 0; n < 4; ++n) { wg[n * 1032 + k] = (bf16_t)f2bf(v0[n] * g); wg[(4 + n) * 1032 + k] = (bf16_t)f2bf(v1[n] * g); }
#pragma unroll
        for (int n = 8; n < 16; ++n) wg[n * 1032 + k] = (bf16_t)0;
    }
    __syncthreads();
    float* gates = (float*)(P.ws + O_GATE);
    const bf16_t* xb = (const bf16_t*)(P.ws + O_XB);
    for (int tile = blockIdx.x * 8 + wid; tile < MV / 16; tile += gridDim.x * 8) {
        const int row = tile * 16 + fr;
        f32x4 acc = {0.f, 0.f, 0.f, 0.f}; float ss = 0.f;
        if (true) {
            const bf16_t* src = xb + tm_off(row, 0, DM) + 8 * fq;
#pragma unroll 16
            for (int ks = 0; ks < 32; ++ks) {
                const bf16x8 a = *(const bf16x8*)(src + (size_t)(ks >> 1) * 16384 + (ks & 1) * 32);
                const bf16x8 bw = *(const bf16x8*)(wg + fr * 1032 + 32 * ks + 8 * fq);
#pragma unroll
                for (int e = 0; e < 8; ++e) { const float x = bf2f(a[e]); ss += x * x; }
                acc = MFMA16(a, bw, acc);
            }
        } else {
            const float* src = P.out + (size_t)row * DM + 8 * fq;
#pragma unroll 4
            for (int ks = 0; ks < 32; ++ks) {
                const f32x4 x0 = *(const f32x4*)(src + 32 * ks), x1 = *(const f32x4*)(src + 32 * ks + 4);
                float f[8] = {x0[0], x0[1], x0[2], x0[3], x1[0], x1[1], x1[2], x1[3]};
#pragma unroll
                for (int e = 0; e < 8; ++e) ss += f[e] * f[e];
                const bf16x8 a = pack8(f);
                const bf16x8 bw = *(const bf16x8*)(wg + fr * 1032 + 32 * ks + 8 * fq);
                acc = MFMA16(a, bw, acc);
            }
        }
        ss += __shfl_xor(ss, 16); ss += __shfl_xor(ss, 32);
        if (fq == 0) lss[wid * 16 + fr] = rsqrtf(ss * (1.f / DM) + EPS);
        if (fr < 8) {
            const float bias = (fr < 4) ? P.bi[fr] : P.bfg[fr - 4];
#pragma unroll
            for (int r = 0; r < 4; ++r) {
                const float v = acc[r] * lss[wid * 16 + 4 * fq + r] + bias;
                const float o = (fr < 4) ? v : (fminf(v, 0.f) - log1pf(expf(-fabsf(v))));
                gates[(size_t)(tile * 16 + 4 * fq + r) * 8 + fr] = o;
            }
        }
    }
    __syncthreads();
}

DI size_t pj(size_t row, int col) {
    return col < 2048 ? ((size_t)(col >> 7) * MP + row) * 128 + (col & 127)
                      : (size_t)16 * MP * 128 + ((size_t)((col - 2048) >> 6) * MP + row) * 64 + (col & 63);
}
constexpr int C_QM = 0, C_KM = 512, C_VM = 1024, C_OM = 1536, C_QA = 2048, C_KA = 2560, C_VA = 2688;

DI float cumsum128(float v, float* red) {
    const int tid = threadIdx.x, lane = tid & 63;
    float cs = v;
#pragma unroll
    for (int o = 1; o < 64; o <<= 1) { const float t = __shfl_up(cs, o); if (lane >= o) cs += t; }
    if (tid == 63) red[0] = cs;
    __syncthreads();
    if (tid >= 64 && tid < 128) cs += red[0];
    __syncthreads();
    return cs;
}
DI float cummax128(float v, float* red) {
    const int tid = threadIdx.x, lane = tid & 63;
    float cs = v;
#pragma unroll
    for (int o = 1; o < 64; o <<= 1) { const float t = __shfl_up(cs, o); if (lane >= o) cs = fmaxf(cs, t); }
    if (tid == 63) red[0] = cs;
    __syncthreads();
    if (tid >= 64 && tid < 128) cs = fmaxf(cs, red[0]);
    __syncthreads();
    return cs;
}

template <int V> DI void m1_item(const Params& P, unsigned char* smem, int item) {
    const int tid = threadIdx.x, lane = tid & 63, wid = tid >> 6, fr = lane & 15, fq = lane >> 4;
    const int c = item & 31, bh = item >> 5, h = bh & 3, b = bh >> 2;
    const size_t row0 = (size_t)b * 4096 + c * 128;
    const bf16_t* proj = (const bf16_t*)(P.ws + O_BIG);
    const float* gates = (const float*)(P.ws + O_GATE);
    bf16_t* Vt = (bf16_t*)smem;
    bf16_t* Kt = Vt + 128 * 136;
    float* fw = (float*)(smem + 2 * 128 * 136 * 2);
    float* red = fw + 128;
    float ip = 0.f, lf = 0.f;
    if (tid < 128) { ip = gates[(row0 + tid) * 8 + h]; lf = gates[(row0 + tid) * 8 + 4 + h]; }
    bf16x8 kreg[4], vreg[4];
#pragma unroll
    for (int i = 0; i < 4; ++i) {
        const int s = tid & 127, dg = (tid >> 7) + 4 * i;
        kreg[i] = *(const bf16x8*)(proj + pj(row0 + s, C_KM + h * 128 + dg * 8));
        vreg[i] = *(const bf16x8*)(proj + pj(row0 + s, C_VM + h * 128 + dg * 8));
    }
    const float cs = cumsum128(lf, red);
    if (tid == 127) red[1] = cs;
    __syncthreads();
    const float blast = red[1];
    const float le = (tid < 128) ? blast - cs + ip : -INFINITY;
    float mx = le;
#pragma unroll
    for (int o = 32; o >= 1; o >>= 1) mx = fmaxf(mx, __shfl_xor(mx, o));
    if (lane == 0 && wid < 2) red[2 + wid] = mx;
    __syncthreads();
    const float mloc = fmaxf(red[2], red[3]);
    if (tid < 128) fw[tid] = __expf(le - mloc);
    __syncthreads();
#pragma unroll
    for (int i = 0; i < 4; ++i) {
        const int s = tid & 127, dg = (tid >> 7) + 4 * i;
        const bf16x8 kv = kreg[i], vv = vreg[i];
        const float w = fw[s];
#pragma unroll
        for (int e = 0; e < 8; ++e) { Kt[(dg * 8 + e) * 136 + s] = kv[e]; Vt[(dg * 8 + e) * 136 + s] = f2bf(bf2f(vv[e]) * w); }
    }
    __syncthreads();
    if (V == 1) { __syncthreads(); return; }
    f32x4 acc[8];
#pragma unroll
    for (int kt = 0; kt < 8; ++kt) acc[kt] = (f32x4){0.f, 0.f, 0.f, 0.f};
#pragma unroll
    for (int ss = 0; ss < 4; ++ss) {
        const bf16x8 bfrag = *(const bf16x8*)(Vt + (16 * wid + fr) * 136 + 32 * ss + 8 * fq);
#pragma unroll
        for (int kt = 0; kt < 8; ++kt) {
            const bf16x8 afrag = *(const bf16x8*)(Kt + (16 * kt + fr) * 136 + 32 * ss + 8 * fq);
            acc[kt] = MFMA16(afrag, bfrag, acc[kt]);
        }
    }
    bf16_t* dC = (bf16_t*)P.out + (size_t)item * 16384;
#pragma unroll
    for (int kt = 0; kt < 8; ++kt) { const f32x4 a = acc[kt] * KSCALE; u32x2 pk; pk[0] = pk_bf16(a[0], a[1]); pk[1] = pk_bf16(a[2], a[3]);
        *(u32x2*)(dC + (16 * wid + fr) * 128 + 16 * kt + 4 * fq) = pk; }
    { const int k = tid >> 2, part = tid & 3; float sum = 0.f;
      for (int s = 32 * part; s < 32 * part + 32; ++s) sum += fw[s] * bf2f(Kt[k * 136 + s]);
      sum += __shfl_xor(sum, 1); sum += __shfl_xor(sum, 2);
      if (part == 0) ((float*)(P.ws + O_DN))[(size_t)item * 128 + k] = sum * KSCALE; }
    if (tid == 0) { ((float*)(P.ws + O_ML))[item] = mloc; ((float*)(P.ws + O_BL))[item] = blast; }
    __syncthreads();
}

DI void scan_phase(const Params& P, unsigned char* smem) {
    const bf16_t* __restrict__ dC = (const bf16_t*)P.out;
    const float* __restrict__ dn = (const float*)(P.ws + O_DN);
    const float* __restrict__ ml = (const float*)(P.ws + O_ML);
    const float* __restrict__ bl = (const float*)(P.ws + O_BL);
    bf16_t* __restrict__ cst = (bf16_t*)(P.ws + O_CST);
    float* __restrict__ nst = (float*)(P.ws + O_NST);
    float* __restrict__ mst = (float*)(P.ws + O_MST);
    float* ldec = (float*)smem; float* lwi = ldec + 32;
    const int tid = threadIdx.x;
    for (int blk = blockIdx.x; blk < 256; blk += gridDim.x) {
        const int bh = blk >> 4;
        if (tid < 32) { ldec[64 + tid] = bl[bh * 32 + tid]; ldec[96 + tid] = ml[bh * 32 + tid]; }
        __syncthreads();
        if (tid == 0) {
            float m = 0.f;
            for (int c = 0; c < 32; ++c) {
                const int item = bh * 32 + c; const float blc = ldec[64 + c], mlc = ldec[96 + c];
                const float mn = fmaxf(blc + m, mlc);
                ldec[c] = __expf(blc + m - mn); lwi[c] = __expf(mlc - mn);
                if ((blk & 15) == 0) mst[item] = m;
                m = mn;
            }
            if ((blk & 15) == 0) P.out[OUT_PM + bh] = m;
        }
        __syncthreads();
        {
            const int e2 = (blk & 15) * 1024 + tid * 2;
            const bf16_t* src = dC + (size_t)bh * 32 * 16384 + e2;
            bf16_t* dst = cst + (size_t)bh * 32 * 16384 + e2;
            f32x2 C = {0.f, 0.f};
#pragma unroll 1
            for (int c0 = 0; c0 < 32; c0 += 8) {
                f32x2 d[8];
#pragma unroll
                for (int j = 0; j < 8; ++j) { const unsigned w = __builtin_nontemporal_load((const unsigned*)(src + (size_t)(c0 + j) * 16384)); d[j][0] = __uint_as_float(w << 16); d[j][1] = __uint_as_float(w & 0xffff0000u); }
#pragma unroll
                for (int j = 0; j < 8; ++j) {
                    *(unsigned*)(dst + (size_t)(c0 + j) * 16384) = pk_bf16(C[0], C[1]);
                    C = ldec[c0 + j] * C + lwi[c0 + j] * d[j];
                }
            }
            *(f32x2*)(P.out + OUT_PC + (size_t)bh * 16384 + e2) = C;
        }
        if ((blk & 15) == 1 && tid < 128) {
            float n = 0.f;
#pragma unroll 1
            for (int c0 = 0; c0 < 32; c0 += 8) {
                float d[8];
#pragma unroll
                for (int j = 0; j < 8; ++j) d[j] = dn[(size_t)(bh * 32 + c0 + j) * 128 + tid];
#pragma unroll
                for (int j = 0; j < 8; ++j) { nst[(size_t)(bh * 32 + c0 + j) * 128 + tid] = n; n = ldec[c0 + j] * n + lwi[c0 + j] * d[j]; }
            }
            P.out[OUT_PN + (size_t)bh * 128 + tid] = n;
        }
        __syncthreads();
    }
}

template <int V> DI void m3_item(const Params& P, unsigned char* smem, int item) {
    const int tid = threadIdx.x, lane = tid & 63, wid = __builtin_amdgcn_readfirstlane(tid >> 6), fr = lane & 15, fq = lane >> 4;
    const int c = item & 31, bh = item >> 5, h = bh & 3, b = bh >> 2;
    const size_t row0 = (size_t)b * 4096 + c * 128;
    const bf16_t* proj = (const bf16_t*)(P.ws + O_BIG);
    const float* gates = (const float*)(P.ws + O_GATE);
    bf16_t* Ks = (bf16_t*)smem;
    bf16_t* Vt = Ks + 128 * 136;
    bf16_t* C0 = Vt + 128 * 136;
    float* fb = (float*)(smem + 3 * 128 * 136 * 2);
    float* fg = fb + 128;
    float* fpm = fg + 128;
    float* fn = fpm + 128;
    float* red = fn + 128;
    float ip = 0.f, lf = 0.f, n0v = 0.f;
    if (tid < 128) { ip = gates[(row0 + tid) * 8 + h]; lf = gates[(row0 + tid) * 8 + 4 + h]; n0v = ((const float*)(P.ws + O_NST))[(size_t)item * 128 + tid]; }
    const float m0 = ((const float*)(P.ws + O_MST))[item];
    const bf16_t* cst = (const bf16_t*)(P.ws + O_CST) + (size_t)item * 16384;
    const int t = 16 * wid + fr; const size_t rowt = row0 + t;
    bf16x8 kreg[4], creg[4], vreg[4], Bq[4]; bf16x4 oreg[8];
#pragma unroll
    for (int i = 0; i < 4; ++i) {
        const int id = tid + 512 * i, s = id >> 4, ch = id & 15;
        kreg[i] = *(const bf16x8*)(proj + pj(row0 + s, C_KM + h * 128 + ch * 8));
        creg[i] = *(const bf16x8*)(cst + s * 128 + ch * 8);
        const int s2 = tid & 127, dg = (tid >> 7) + 4 * i;
        vreg[i] = *(const bf16x8*)(proj + pj(row0 + s2, C_VM + h * 128 + dg * 8));
    }
#pragma unroll
    for (int ks = 0; ks < 4; ++ks) Bq[ks] = *(const bf16x8*)(proj + pj(rowt, C_QM + h * 128 + 32 * ks + 8 * fq));
#pragma unroll
    for (int vt = 0; vt < 8; ++vt) oreg[vt] = *(const bf16x4*)(proj + pj(rowt, C_OM + h * 128 + 16 * vt + 4 * fq));
    const float cs = cumsum128(lf, red);
    const float gg = ip - cs;
    const float pm = cummax128(tid < 128 ? gg : -INFINITY, red);
    if (tid < 128) { fb[tid] = cs; fg[tid] = gg; fpm[tid] = pm; fn[tid] = n0v; }
#pragma unroll
    for (int i = 0; i < 4; ++i) {
        const int id = tid + 512 * i, s = id >> 4, ch = id & 15;
        *(bf16x8*)(Ks + s * 136 + ch * 8) = kreg[i];
        *(bf16x8*)(C0 + s * 136 + ch * 8) = creg[i];
        const int s2 = tid & 127, dg = (tid >> 7) + 4 * i;
#pragma unroll
        for (int e = 0; e < 8; ++e) Vt[(dg * 8 + e) * 136 + s2] = vreg[i][e];
    }
    __syncthreads();
    if (V == 1) { __syncthreads(); return; }
    float nq = 0.f;
#pragma unroll
    for (int ks = 0; ks < 4; ++ks)
#pragma unroll
        for (int e = 0; e < 8; ++e) nq += fn[32 * ks + 8 * fq + e] * bf2f(Bq[ks][e]);
    nq += __shfl_xor(nq, 16); nq += __shfl_xor(nq, 32);
    const float Mt = fmaxf(m0, fpm[t]); const float winter = __expf(m0 - Mt);
    f32x4 accP[8];
#pragma unroll
    for (int vt = 0; vt < 8; ++vt) accP[vt] = (f32x4){0.f, 0.f, 0.f, 0.f};
    {
        bf16x8 Bqs[4];
#pragma unroll
        for (int ks = 0; ks < 4; ++ks) { float f[8];
#pragma unroll
            for (int e = 0; e < 8; ++e) f[e] = bf2f(Bq[ks][e]) * winter;
            Bqs[ks] = pack8(f); }
#pragma unroll
        for (int ks = 0; ks < 4; ++ks) {
#pragma unroll
            for (int vt = 0; vt < 8; ++vt) {
                const bf16x8 a = *(const bf16x8*)(C0 + (16 * vt + fr) * 136 + 32 * ks + 8 * fq);
                accP[vt] = MFMA16(a, Bqs[ks], accP[vt]);
            }
            asm volatile("" ::: "memory");
        }
    }
    float psum = 0.f;
    const int npair = (wid >> 1) + 1;
#pragma unroll 1
    for (int p = 0; p < npair; ++p) {
        asm volatile("" ::: "memory");
        f32x4 S0 = {0.f, 0.f, 0.f, 0.f}, S1 = {0.f, 0.f, 0.f, 0.f};
#pragma unroll
        for (int ks = 0; ks < 4; ++ks) {
            const bf16x8 a0 = *(const bf16x8*)(Ks + (32 * p + fr) * 136 + 32 * ks + 8 * fq);
            const bf16x8 a1 = *(const bf16x8*)(Ks + (32 * p + 16 + fr) * 136 + 32 * ks + 8 * fq);
            S0 = MFMA16(a0, Bq[ks], S0); S1 = MFMA16(a1, Bq[ks], S1);
        }
        float pv[8];
#pragma unroll
        for (int r = 0; r < 4; ++r) {
            const int s0 = 32 * p + 4 * fq + r, s1 = s0 + 16;
            const float d0 = (s0 <= t) ? __expf(fg[s0] - Mt) : 0.f;
            const float d1 = (s1 <= t) ? __expf(fg[s1] - Mt) : 0.f;
            pv[r] = (s0 <= t) ? S0[r] * KSCALE * d0 : 0.f; pv[4 + r] = (s1 <= t) ? S1[r] * KSCALE * d1 : 0.f;
            psum += pv[r] + pv[4 + r];
        }
        const bf16x8 Bp = pack8(pv);
#pragma unroll
        for (int vt = 0; vt < 8; ++vt) {
            const bf16x4 lo = *(const bf16x4*)(Vt + (16 * vt + fr) * 136 + 32 * p + 4 * fq);
            const bf16x4 hi = *(const bf16x4*)(Vt + (16 * vt + fr) * 136 + 32 * p + 16 + 4 * fq);
            const bf16x8 a = {lo[0], lo[1], lo[2], lo[3], hi[0], hi[1], hi[2], hi[3]};
            accP[vt] = MFMA16(a, Bp, accP[vt]);
        }
    }
    psum += __shfl_xor(psum, 16); psum += __shfl_xor(psum, 32);
    const float den = winter * nq + psum, mt = fb[t] + Mt;
    const float inv = 1.f / fmaxf(fabsf(den), __expf(-mt));
    float ssq = 0.f;
#pragma unroll
    for (int vt = 0; vt < 8; ++vt)
#pragma unroll
        for (int r = 0; r < 4; ++r) { const float hv = accP[vt][r] * inv; accP[vt][r] = hv; ssq += hv * hv; }
    ssq += __shfl_xor(ssq, 16); ssq += __shfl_xor(ssq, 32);
    const float rn = rsqrtf(ssq * (1.f / 128.f) + EPS);
    bf16_t* ymix = (bf16_t*)(P.ws + O_YMIX);
#pragma unroll
    for (int vt = 0; vt < 8; ++vt) {
        const int v0 = 16 * vt + 4 * fq;
        const bf16x4 o4 = oreg[vt];
        const f32x4 g4 = *(const f32x4*)(P.gout + h * 128 + v0);
        float y[4];
#pragma unroll
        for (int r = 0; r < 4; ++r) y[r] = accP[vt][r] * rn * g4[r] * sigmoidf_(bf2f(o4[r]));
        u32x2 pk; pk[0] = pk_bf16(y[0], y[1]); pk[1] = pk_bf16(y[2], y[3]);
        *(u32x2*)(ymix + tm_off(rowt, h * 128 + v0, DM)) = pk;
    }
    __syncthreads();
}

template <int V> DI void swa_item(const Params& P, unsigned char* smem, int item) {
    const int tid = threadIdx.x, lane = tid & 63, wid = __builtin_amdgcn_readfirstlane(tid >> 6), fr = lane & 15, fq = lane >> 4;
    const int kvh = item & 1, nb = (item >> 1) & 31, b = item >> 6;
    const bf16_t* proj = (const bf16_t*)(P.ws + O_BIG);
    bf16_t* Kn = (bf16_t*)smem;
    bf16_t* Vt = Kn + 256 * 72;
    const long row0 = (long)b * 4096 + (long)(nb - 1) * 128;
    const int qi = 16 * wid + fr;
    const size_t qrow = (size_t)b * 4096 + nb * 128 + qi;
    bf16x8 Qn[2];
#pragma unroll
    for (int ks = 0; ks < 2; ++ks) Qn[ks] = *(const bf16x8*)(proj + pj(qrow, C_QA + (kvh * 4) * 64 + 32 * ks + 8 * fq));
    bf16x8 kraw[4], vraw[4];
#pragma unroll
    for (int i = 0; i < 4; ++i) {
        const int id = tid + 512 * i;
        { const int j = id >> 3, ch = id & 7; const bool valid = (V != 2) && ((nb > 0) || (j >= 128));
          kraw[i] = (bf16x8){0, 0, 0, 0, 0, 0, 0, 0};
          if (valid) kraw[i] = *(const bf16x8*)(proj + pj((size_t)(row0 + j), C_KA + kvh * 64 + ch * 8)); }
        { const int j = id & 255, ch = id >> 8; const bool valid = (V != 2) && ((nb > 0) || (j >= 128));
          vraw[i] = (bf16x8){0, 0, 0, 0, 0, 0, 0, 0};
          if (valid) vraw[i] = *(const bf16x8*)(proj + pj((size_t)(row0 + j), C_VA + kvh * 64 + ch * 8)); }
    }
#pragma unroll
    for (int i = 0; i < 4; ++i) {
        const int id = tid + 512 * i, j = id >> 3, ch = id & 7;
        const bf16x8 kv = kraw[i];
        float f[8]; float ss = 0.f;
#pragma unroll
        for (int e = 0; e < 8; ++e) { f[e] = bf2f(kv[e]); ss += f[e] * f[e]; }
        ss += __shfl_xor(ss, 1); ss += __shfl_xor(ss, 2); ss += __shfl_xor(ss, 4);
        const float rs = rsqrtf(ss * (1.f / 64.f) + EPS);
        const f32x4 g0 = *(const f32x4*)(P.gk + ch * 8), g1 = *(const f32x4*)(P.gk + ch * 8 + 4);
#pragma unroll
        for (int e = 0; e < 4; ++e) { f[e] *= rs * g0[e]; f[4 + e] *= rs * g1[e]; }
        *(bf16x8*)(Kn + j * 72 + ch * 8) = pack8(f);
        if (nb == 31 && j >= 128) {
            float* dst = P.out + OUT_PK + ((size_t)(b * 128 + (j - 128)) * 2 + kvh) * 64 + ch * 8;
            *(f32x4*)dst = (f32x4){f[0], f[1], f[2], f[3]}; *(f32x4*)(dst + 4) = (f32x4){f[4], f[5], f[6], f[7]};
        }
    }
#pragma unroll
    for (int i = 0; i < 4; ++i) {
        const int id = tid + 512 * i, j = id & 255, ch = id >> 8;
        const bf16x8 vv = vraw[i];
#pragma unroll
        for (int e = 0; e < 8; ++e) Vt[(ch * 8 + e) * 264 + j] = vv[e];
        if (nb == 31 && j >= 128) {
            float* dst = P.out + OUT_PV + ((size_t)(b * 128 + (j - 128)) * 2 + kvh) * 64 + ch * 8;
            *(f32x4*)dst = (f32x4){bf2f(vv[0]), bf2f(vv[1]), bf2f(vv[2]), bf2f(vv[3])}; *(f32x4*)(dst + 4) = (f32x4){bf2f(vv[4]), bf2f(vv[5]), bf2f(vv[6]), bf2f(vv[7])};
        }
    }
    __syncthreads();
    bf16_t* ymix = (bf16_t*)(P.ws + O_YMIX);
    const int st0 = 2 * (wid >> 1);
#pragma unroll 1
    for (int hh = 0; hh < 4; ++hh) {
        const int head = kvh * 4 + hh;
        bf16x8 Qc[2] = {Qn[0], Qn[1]};
        if (hh < 3) {
#pragma unroll
            for (int ks = 0; ks < 2; ++ks) Qn[ks] = *(const bf16x8*)(proj + pj(qrow, C_QA + (head + 1) * 64 + 32 * ks + 8 * fq));
        }
        bf16x8 Bq[2];
        { float f[16]; float ss = 0.f;
#pragma unroll
          for (int ks = 0; ks < 2; ++ks) { const bf16x8 q = Qc[ks];
#pragma unroll
              for (int e = 0; e < 8; ++e) { f[ks * 8 + e] = bf2f(q[e]); ss += f[ks * 8 + e] * f[ks * 8 + e]; } }
          ss += __shfl_xor(ss, 16); ss += __shfl_xor(ss, 32);
          const float rs = rsqrtf(ss * (1.f / 64.f) + EPS) * 0.125f;
#pragma unroll
          for (int ks = 0; ks < 2; ++ks) {
              const f32x4 g0 = *(const f32x4*)(P.gq + 32 * ks + 8 * fq), g1 = *(const f32x4*)(P.gq + 32 * ks + 8 * fq + 4);
#pragma unroll
              for (int e = 0; e < 4; ++e) { f[ks * 8 + e] *= rs * g0[e]; f[ks * 8 + 4 + e] *= rs * g1[e]; }
              Bq[ks] = pack8(f + ks * 8);
          } }
        f32x4 S[10];
#pragma unroll
        for (int i = 0; i < 10; ++i) {
            S[i] = (f32x4){0.f, 0.f, 0.f, 0.f};
#pragma unroll
            for (int ks = 0; ks < 2; ++ks) {
                const bf16x8 a = *(const bf16x8*)(Kn + (16 * (st0 + i) + fr) * 72 + 32 * ks + 8 * fq);
                S[i] = MFMA16(a, Bq[ks], S[i]);
            }
            if ((i & 3) == 3) asm volatile("" ::: "memory");
        }
        const float sink = P.sinks[head];
        float mx = sink;
#pragma unroll
        for (int i = 0; i < 10; ++i)
#pragma unroll
            for (int r = 0; r < 4; ++r) {
                const int j = 16 * (st0 + i) + 4 * fq + r;
                const bool ok = (j >= qi) && (j <= qi + 128) && ((nb > 0) || (j >= 128));
                S[i][r] = ok ? S[i][r] : -INFINITY;
                mx = fmaxf(mx, S[i][r]);
            }
        mx = fmaxf(mx, __shfl_xor(mx, 16)); mx = fmaxf(mx, __shfl_xor(mx, 32));
        float sum = 0.f;
#pragma unroll
        for (int i = 0; i < 10; ++i)
#pragma unroll
            for (int r = 0; r < 4; ++r) { const float pe = __expf(S[i][r] - mx); S[i][r] = pe; sum += pe; }
        sum += __shfl_xor(sum, 16); sum += __shfl_xor(sum, 32);
        const float invden = 1.f / (sum + __expf(sink - mx));
        f32x4 O[4];
#pragma unroll
        for (int dt = 0; dt < 4; ++dt) O[dt] = (f32x4){0.f, 0.f, 0.f, 0.f};
#pragma unroll
        for (int pp = 0; pp < 5; ++pp) {
            float pv[8];
#pragma unroll
            for (int r = 0; r < 4; ++r) { pv[r] = S[2 * pp][r]; pv[4 + r] = S[2 * pp + 1][r]; }
            const bf16x8 Bp = pack8(pv);
#pragma unroll
            for (int dt = 0; dt < 4; ++dt) {
                const bf16x4 lo = *(const bf16x4*)(Vt + (16 * dt + fr) * 264 + 16 * (st0 + 2 * pp) + 4 * fq);
                const bf16x4 hi = *(const bf16x4*)(Vt + (16 * dt + fr) * 264 + 16 * (st0 + 2 * pp) + 16 + 4 * fq);
                const bf16x8 a = {lo[0], lo[1], lo[2], lo[3], hi[0], hi[1], hi[2], hi[3]};
                O[dt] = MFMA16(a, Bp, O[dt]);
            }
            asm volatile("" ::: "memory");
        }
#pragma unroll
        for (int dt = 0; dt < 4; ++dt) {
            u32x2 pk; pk[0] = pk_bf16(O[dt][0] * invden, O[dt][1] * invden); pk[1] = pk_bf16(O[dt][2] * invden, O[dt][3] * invden);
            *(u32x2*)(ymix + tm_off(qrow, 512 + head * 64 + 16 * dt + 4 * fq, DM)) = pk;
        }
    }
    __syncthreads();
}

DI void smlstm_item(const Params& P, unsigned char* smem, int item) {
    const int tid = threadIdx.x, lane = tid & 63, wid = tid >> 6;
    const int h = item & 3, b = item >> 2;
    const size_t r = (size_t)TP + b;
    const bf16_t* proj = (const bf16_t*)(P.ws + O_BIG);
    const float* gates = (const float*)(P.ws + O_GATE);
    float* lq = (float*)smem; float* lk = lq + 128; float* lv = lk + 128; float* lcq = lv + 128; float* red = lcq + 128;
    const int sub = tid & 31, vr = tid >> 5;
    const float* __restrict__ Cin = P.sC + (size_t)item * 16384; float* __restrict__ Cout = P.out + OUT_SC + (size_t)item * 16384;
    f32x4 creg[8];
#pragma unroll
    for (int it = 0; it < 8; ++it) creg[it] = __builtin_nontemporal_load((const f32x4*)(Cin + (vr + 16 * it) * 128 + 4 * sub));
    float q = 0.f, k = 0.f, v = 0.f, n0 = 0.f;
    if (tid < 128) {
        q = bf2f(proj[pj(r, C_QM + h * 128 + tid)]); k = bf2f(proj[pj(r, C_KM + h * 128 + tid)]) * KSCALE; v = bf2f(proj[pj(r, C_VM + h * 128 + tid)]);
        n0 = P.sn[(size_t)item * 128 + tid];
        lq[tid] = q; lk[tid] = k; lv[tid] = v;
    }
    float qk = q * k, nq = n0 * q;
#pragma unroll
    for (int o = 32; o >= 1; o >>= 1) { qk += __shfl_xor(qk, o); nq += __shfl_xor(nq, o); }
    if (lane == 0 && wid < 2) { red[wid] = qk; red[2 + wid] = nq; }
    __syncthreads();
    qk = red[0] + red[1]; nq = red[2] + red[3];
    const float ip = gates[r * 8 + h], lf = gates[r * 8 + 4 + h], m0 = P.sm[item];
    const float mnew = fmaxf(lf + m0, ip), decay = __expf(lf + m0 - mnew), wend = __expf(ip - mnew);
    const float score = qk * wend;
    {
        const f32x4 q4 = *(const f32x4*)(lq + 4 * sub), k4 = *(const f32x4*)(lk + 4 * sub);
#pragma unroll
        for (int it = 0; it < 8; ++it) {
            const int vv = vr + 16 * it;
            const f32x4 cc = creg[it];
            float part = cc[0] * q4[0] + cc[1] * q4[1] + cc[2] * q4[2] + cc[3] * q4[3];
            const float wv = wend * lv[vv];
            __builtin_nontemporal_store(decay * cc + wv * k4, (f32x4*)(Cout + vv * 128 + 4 * sub));
#pragma unroll
            for (int o = 16; o >= 1; o >>= 1) part += __shfl_xor(part, o);
            if (sub == 0) lcq[vv] = part;
        }
    }
    __syncthreads();
    float hv = 0.f;
    if (tid < 128) {
        const float num = decay * lcq[tid] + score * v, den = decay * nq + score;
        hv = num / fmaxf(fabsf(den), __expf(-mnew));
        P.out[OUT_SN + (size_t)item * 128 + tid] = decay * n0 + wend * k;
        if (tid == 0) P.out[OUT_SM + item] = mnew;
    }
    float ssq = hv * hv;
#pragma unroll
    for (int o = 32; o >= 1; o >>= 1) ssq += __shfl_xor(ssq, o);
    if (lane == 0 && wid < 2) red[4 + wid] = ssq;
    __syncthreads();
    if (tid < 128) {
        const float rn = rsqrtf((red[4] + red[5]) * (1.f / 128.f) + EPS);
        const float o = bf2f(proj[pj(r, C_OM + h * 128 + tid)]);
        ((bf16_t*)(P.ws + O_YMIX))[tm_off(r, h * 128 + tid, DM)] = (bf16_t)f2bf(hv * rn * P.gout[h * 128 + tid] * sigmoidf_(o));
    }
    __syncthreads();
}

DI void sswa_item(const Params& P, unsigned char* smem, int item) {
    const int tid = threadIdx.x, lane = tid & 63, wid = tid >> 6;
    const int kvh = item & 1, b = item >> 1;
    const size_t r = (size_t)TP + b;
    const bf16_t* proj = (const bf16_t*)(P.ws + O_BIG);
    float* Kc = (float*)smem;
    float* Vc = Kc + 129 * 64;
    float* lq = Vc + 129 * 64;
    float* lp = lq + 256;
    const float* ckb = P.ck + (size_t)b * 16384 + kvh * 64; const float* cvb = P.cv + (size_t)b * 16384 + kvh * 64;
#pragma unroll
    for (int i = 0; i < 4; ++i) {
        const int id = tid + 512 * i, j = id >> 4, q4 = (id & 15) * 4;
        *(f32x4*)(Kc + j * 64 + q4) = __builtin_nontemporal_load((const f32x4*)(ckb + j * 128 + q4));
        *(f32x4*)(Vc + j * 64 + q4) = __builtin_nontemporal_load((const f32x4*)(cvb + j * 128 + q4));
    }
    if (tid < 256) {
        const float qraw = bf2f(proj[pj(r, C_QA + kvh * 256 + tid)]);
        float ss = qraw * qraw;
#pragma unroll
        for (int o = 32; o >= 1; o >>= 1) ss += __shfl_xor(ss, o);
        lq[tid] = qraw * rsqrtf(ss * (1.f / 64.f) + EPS) * P.gq[lane] * 0.125f;
    } else if (tid < 320) {
        const float kraw = bf2f(proj[pj(r, C_KA + kvh * 64 + lane)]);
        float s2 = kraw * kraw;
#pragma unroll
        for (int o = 32; o >= 1; o >>= 1) s2 += __shfl_xor(s2, o);
        Kc[128 * 64 + lane] = kraw * rsqrtf(s2 * (1.f / 64.f) + EPS) * P.gk[lane];
        Vc[128 * 64 + lane] = bf2f(proj[pj(r, C_VA + kvh * 64 + lane)]);
    }
    __syncthreads();
    {
        float* okb = P.out + OUT_SK + (size_t)b * 16384 + kvh * 64; float* ovb = P.out + OUT_SV + (size_t)b * 16384 + kvh * 64;
#pragma unroll
        for (int i = 0; i < 4; ++i) {
            const int id = tid + 512 * i, j = id >> 4, q4 = (id & 15) * 4;
            __builtin_nontemporal_store(*(const f32x4*)(Kc + (j + 1) * 64 + q4), (f32x4*)(okb + j * 128 + q4));
            __builtin_nontemporal_store(*(const f32x4*)(Vc + (j + 1) * 64 + q4), (f32x4*)(ovb + j * 128 + q4));
        }
    }
    for (int idx = tid; idx < 4 * 129; idx += 512) {
        const int head = idx / 129, j = idx - head * 129;
        float s = 0.f;
#pragma unroll 8
        for (int d = 0; d < 64; ++d) { const int dd = (d + lane) & 63; s += Kc[j * 64 + dd] * lq[head * 64 + dd]; }
        lp[head * 132 + j] = s;
    }
    __syncthreads();
    if (wid < 4) {
        const int head = wid; const float sink = P.sinks[kvh * 4 + head];
        const float s0 = lp[head * 132 + lane], s1 = lp[head * 132 + 64 + lane], s2 = (lane == 0) ? lp[head * 132 + 128] : -INFINITY;
        float mx = fmaxf(fmaxf(s0, s1), fmaxf(s2, sink));
#pragma unroll
        for (int o = 32; o >= 1; o >>= 1) mx = fmaxf(mx, __shfl_xor(mx, o));
        const float p0 = __expf(s0 - mx), p1 = __expf(s1 - mx), p2 = (lane == 0) ? __expf(s2 - mx) : 0.f;
        float sum = p0 + p1 + p2;
#pragma unroll
        for (int o = 32; o >= 1; o >>= 1) sum += __shfl_xor(sum, o);
        const float inv = 1.f / (sum + __expf(sink - mx));
        lp[head * 132 + lane] = p0 * inv; lp[head * 132 + 64 + lane] = p1 * inv; if (lane == 0) lp[head * 132 + 128] = p2 * inv;
    }
    __syncthreads();
    if (wid < 4) {
        const int head = wid; float o = 0.f;
#pragma unroll 4
        for (int j = 0; j < 129; ++j) o += lp[head * 132 + j] * Vc[j * 64 + lane];
        ((bf16_t*)(P.ws + O_YMIX))[tm_off(r, 512 + (kvh * 4 + head) * 64 + lane, DM)] = (bf16_t)f2bf(o);
    }
    __syncthreads();
}

constexpr int NPHASE = 10;
#ifndef PHMASK
#define PHMASK 0x3ff
#endif
#define PHEN(p) ((PHMASK >> (p)) & 1)
#ifndef ITMASK
#define ITMASK 0xf
#endif
#define ITEN(p) ((ITMASK >> (p)) & 1)
#ifndef RPTITMASK
#define RPTITMASK 0xf
#endif
#define RPTIT(p) ((RPTITMASK >> (p)) & 1)
#ifndef RPTVAR
#define RPTVAR 0
#endif
template <bool LAST> DI void sample_strip_gemm(const Params& P, unsigned char* smem, const bf16_t* A, const bf16_t* Bt, int K, float scale) {
    const int lane = threadIdx.x & 63, wid = threadIdx.x >> 6, fr = lane & 15, fq = lane >> 4;
    const int rt = wid & 1, kq = wid >> 1;
    f32x4* red = (f32x4*)smem;
    const int nks = K / 128;
    for (int u = blockIdx.x; u < 256; u += gridDim.x) {
        const int cgp = u & 63, rg = u >> 6;
        const size_t rbase = (size_t)TP + 32 * rg + 16 * rt;
        const bf16_t* ap = A + tm_off(rbase + fr, 0, K) + 8 * fq;
        const bf16_t* bp = Bt + tm_off((size_t)16 * cgp + fr, 0, K) + 8 * fq;
        f32x4 acc0 = {0.f, 0.f, 0.f, 0.f}, acc1 = {0.f, 0.f, 0.f, 0.f};
#pragma unroll 6
        for (int ks = kq * nks; ks < (kq + 1) * nks; ks += 2) {
            const size_t o = (size_t)(ks >> 1) * 16384;
            const bf16x8 a0 = *(const bf16x8*)(ap + o), b0 = *(const bf16x8*)(bp + o);
            const bf16x8 a1 = *(const bf16x8*)(ap + o + 32), b1 = *(const bf16x8*)(bp + o + 32);
            acc0 = MFMA16(a0, b0, acc0); acc1 = MFMA16(a1, b1, acc1);
        }
        red[wid * 64 + lane] = acc0 + acc1;
        __syncthreads();
        if (wid < 2) {
            const f32x4 t = red[(0 + rt) * 64 + lane] + red[(2 + rt) * 64 + lane] + red[(4 + rt) * 64 + lane] + red[(6 + rt) * 64 + lane];
            bf16_t* xb = (bf16_t*)(P.ws + O_XB);
#pragma unroll
            for (int r = 0; r < 4; ++r) {
                const size_t row = rbase + 4 * fq + r; const int col = 16 * cgp + fr;
                float* op = P.out + row * DM + col;
                const float v = *op + scale * t[r];
                *op = v;
                if (!LAST) xb[tm_off(row, col, DM)] = (bf16_t)f2bf(v);
            }
        }
        __syncthreads();
    }
}

#define XB_TMO      128
#define XB_XCNT(j)  (256  + 64 * (j))
#define XB_XSUB(j)  (1280 + 64 * (j))
#define XB_XGEN(j)  (2304 + 64 * (j))
#define XB_TOP      3328
#define XB_TOPGEN   3392
#define XCD_BAR_WORDS 3456
#define XB_SPIN_CAP (1u << 18)
DI unsigned xb_ld(unsigned* p)              { return __hip_atomic_load(p, __ATOMIC_RELAXED, __HIP_MEMORY_SCOPE_AGENT); }
DI unsigned xb_add(unsigned* p, unsigned v) { return __hip_atomic_fetch_add(p, v, __ATOMIC_RELAXED, __HIP_MEMORY_SCOPE_AGENT); }
DI unsigned xb_xcc_id() { return (unsigned)__builtin_amdgcn_s_getreg((3 << 11) | 20) & 0xFu; }
#define XB_SPIN(cond, bar) do { unsigned _sp = 0; while (cond) { __builtin_amdgcn_s_sleep(1); \
    if ((++_sp & 255u) == 0u) { if (xb_ld(&(bar)[XB_TMO])) break; if (_sp > XB_SPIN_CAP) { atomicAdd(&(bar)[XB_TMO], 1u); break; } } } } while (0)
struct XcdBarrier { unsigned* bar; unsigned x; volatile LAS unsigned* st; };
DI XcdBarrier xcd_barrier_post(unsigned* bar, volatile LAS unsigned* st) {
    XcdBarrier b; b.bar = bar; b.x = xb_xcc_id(); b.st = st;
    if (threadIdx.x == 0) (void)xb_add(&bar[XB_XCNT(b.x)], 1u);
    return b;
}
DI void xcd_barrier_complete(unsigned* bar, unsigned x, unsigned& nloc, unsigned& nx) {
    const unsigned G = gridDim.x * gridDim.y * gridDim.z;
    unsigned sum, cnt, mine, sp = 0u;
    for (;;) {
        sum = 0u; cnt = 0u; mine = 0u;
#pragma unroll
        for (unsigned j = 0; j < 16; ++j) { const unsigned c = xb_ld(&bar[XB_XCNT(j)]); sum += c; cnt += (c > 0u) ? 1u : 0u; mine = (j == x) ? c : mine; }
        if (sum == G) break;
        __builtin_amdgcn_s_sleep(1);
        if ((++sp & 255u) == 0u) { if (xb_ld(&bar[XB_TMO])) break; if (sp > XB_SPIN_CAP) { atomicAdd(&bar[XB_TMO], 1u); break; } }
    }
    nloc = mine > 0u ? mine : 1u; nx = cnt > 0u ? cnt : 1u;
}
DI void xcd_barrier(const XcdBarrier& b) {
    asm volatile("s_waitcnt vmcnt(0)" ::: "memory");
    __syncthreads();
    if (threadIdx.x == 0) {
        unsigned* bar = b.bar;
        __builtin_amdgcn_s_waitcnt(0);
        unsigned nloc = b.st[0], nx = b.st[1];
        if (nloc == 0u) { xcd_barrier_complete(bar, b.x, nloc, nx); b.st[0] = nloc; b.st[1] = nx; }
        const unsigned old = xb_add(&bar[XB_XSUB(b.x)], 1u);
        const unsigned gen = old / nloc;
        if (old + 1u == (gen + 1u) * nloc) {
            __builtin_amdgcn_fence(__ATOMIC_RELEASE, "agent");
            asm volatile("s_waitcnt vmcnt(0)" ::: "memory");
            const unsigned og = xb_add(&bar[XB_TOP], 1u);
            const unsigned tg = og / nx;
            if (og + 1u == (tg + 1u) * nx) xb_add(&bar[XB_TOPGEN], 1u);
            else XB_SPIN(xb_ld(&bar[XB_TOPGEN]) == tg, bar);
            __builtin_amdgcn_fence(__ATOMIC_ACQUIRE, "agent");
            xb_add(&bar[XB_XGEN(b.x)], 1u);
            asm volatile("s_waitcnt vmcnt(0)" ::: "memory");
        } else {
            XB_SPIN(xb_ld(&bar[XB_XGEN(b.x)]) == gen, bar);
            __builtin_amdgcn_fence(__ATOMIC_ACQUIRE, "agent");
            asm volatile("s_waitcnt vmcnt(0)" ::: "memory");
        }
    }
    __syncthreads();
}

constexpr size_t O_PRIV = WS_TOTAL;
constexpr size_t WS_TOTAL2 = O_PRIV + (size_t)256 * 256 * DM * 2 / 8;
constexpr size_t O_BAR = WS_TOTAL2;
constexpr size_t WS_TOTAL3 = O_BAR + AL(XCD_BAR_WORDS * 4);
static_assert(WS_TOTAL3 <= (size_t)256 * 1024 * 1024, "workspace too large");
template <int K, bool RPT = false> DI void run_phase(const Params& P, unsigned char* smem) {
    LAS unsigned char* lds = (LAS unsigned char*)smem;
    pg8::MixOrder S;
    const int G = gridDim.x, c = blockIdx.x;
    bf16_t* xb = (bf16_t*)(P.ws + O_XB); bf16_t* big = (bf16_t*)(P.ws + O_BIG); float* ssq = (float*)(P.ws + O_SSQ);
    if constexpr (K == 0) phase0(P, smem);
    if constexpr (K == 1) {
        pg8::Gemm g{xb, xb + (size_t)TP * DM, (const bf16_t*)(P.ws + O_WGU1), DM};
        S.init(2 * FF, DM, G, c, G - 22 > 0 ? G - 22 : 0, 22, 1, 0);
        prep_rstd(smem, ssq, 1, S, nullptr);
        EpiSwiGLU E{big, (const LAS float*)(lds + RSL_OFF)};
        pg8::gemm_phase(lds, g, S, E);
        if (!RPT && G == 256 && c >= 128 && c < 234) {
            convert_list(P, (float*)smem, c - 128, 528, 106, [](int j) { return j < 352 ? 352 + j : 768 + (j - 352); });
        }
    }
    if constexpr (K == 8) {
        pg8::Gemm g{xb, xb + (size_t)TP * DM, (const bf16_t*)(P.ws + O_WGU2), DM};
        S.init(2 * FF, DM, G, c, G - 22 > 0 ? G - 22 : 0, 22, 1, 0);
        prep_rstd(smem, ssq, 16, S, xb);
        EpiSwiGLU E{big, (const LAS float*)(lds + RSL_OFF)};
        pg8::gemm_phase(lds, g, S, E);
        if (!RPT && G == 256 && c >= 128 && c < 234) {
            convert_list(P, (float*)smem, c - 128, 176, 106, [](int j) { return 1120 + j; });
        }
    }
    if constexpr (K == 2) {
        if (!RPT) sample_strip_gemm<false>(P, smem, big, (const bf16_t*)(P.ws + O_WD1), FF, 0.5f);
        pg8::Gemm g{big, big + (size_t)TP * FF, (const bf16_t*)(P.ws + O_WD1), FF};
        S.init(DM, FF, G, c, 0, 0, 2, 4);
        EpiResid<false> E{P.out, RPT ? 0.f : 0.5f, xb, ssq};
        pg8::gemm_phase(lds, g, S, E);
    }
    if constexpr (K == 3) {
        pg8::Gemm g{xb, xb + (size_t)TP * DM, (const bf16_t*)(P.ws + O_WIN), DM};
        S.init(PW, DM, G, c, G - 11 > 0 ? G - 11 : 0, 11, 1, 0);
        prep_rstd(smem, ssq, 16, S, xb);
        EpiRowScale E{big, PW, (const LAS float*)(lds + RSL_OFF)};
        pg8::gemm_phase(lds, g, S, E);
        if (!RPT && G == 256 && c >= 192 && c < 245) {
            convert_list(P, (float*)smem, c - 192, 240, 53, [](int j) { return j < 64 ? 704 + j : 944 + (j - 64); });
        }
        gates_pass(P, smem);
    }
    if constexpr (K == 4) {
        const int nk = (1536 + (int)gridDim.x - 1) / (int)gridDim.x, rot = ((int)blockIdx.x % 3) * 2;
        for (int kk = 0; kk < nk; ++kk) {
            const int k = (kk + rot) % nk; const int it = blockIdx.x + k * gridDim.x;
            if (it >= 1536) continue;
            Params Q = P;
            asm volatile("" : "+s"(Q.ws), "+s"(Q.out));
            if (it < 512) { if (!RPT) m1_item<0>(Q, smem, it); else if (RPTIT(0)) m1_item<RPTVAR>(Q, smem, it); }
            else if (it < 768) { if (!RPT) swa_item<0>(Q, smem, it - 512); else if (RPTIT(1)) swa_item<RPTVAR>(Q, smem, it - 512); }
            else if (it < 1280) { if (!RPT || RPTIT(2)) smlstm_item(Q, smem, it - 768); }
            else { if (!RPT || RPTIT(3)) sswa_item(Q, smem, it - 1280); }
        }
    }
    if constexpr (K == 5) scan_phase(P, smem);
    if constexpr (K == 6) { for (int it = blockIdx.x; it < 512; it += gridDim.x) { if (!RPT) m3_item<0>(P, smem, it); else m3_item<RPTVAR>(P, smem, it); } }
    if constexpr (K == 7) {
        bf16_t* ym = (bf16_t*)(P.ws + O_YMIX);
        if (!RPT) sample_strip_gemm<false>(P, smem, ym, (const bf16_t*)(P.ws + O_WOUT), DM, 1.0f);
        pg8::Gemm g{ym, ym + (size_t)TP * DM, (const bf16_t*)(P.ws + O_WOUT), DM};
        S.init(DM, DM, G, c, 0, 0, 2, 4);
        EpiResid<false> E{P.out, RPT ? 0.f : 1.0f, xb, ssq};
        pg8::gemm_phase(lds, g, S, E);
    }
    if constexpr (K == 9) {
        if (!RPT) sample_strip_gemm<true>(P, smem, big, (const bf16_t*)(P.ws + O_WD2), FF, 0.5f);
        pg8::Gemm g{big, big + (size_t)TP * FF, (const bf16_t*)(P.ws + O_WD2), FF};
        S.init(DM, FF, G, c, 0, 0, 2, 4);
        EpiResid<true> E{P.out, RPT ? 0.f : 0.5f, xb, nullptr};
        pg8::gemm_phase(lds, g, S, E);
    }
}
#ifndef REPMASK
#define REPMASK 0
#endif
#define REP(k) ((REPMASK >> (k)) & 1)
__global__ void __launch_bounds__(512) hymba_megakernel(Params P, int ph_lo, int ph_hi) {
    extern __shared__ __attribute__((aligned(16))) unsigned char smem[];
    cg::grid_group grid = cg::this_grid();
    if (ph_lo < 0) grid.sync();
    volatile LAS unsigned* st = (volatile LAS unsigned*)((LAS unsigned char*)smem + (LDS_BYTES - 16));
    if (threadIdx.x == 0) { st[0] = 0u; st[1] = 0u; }
    __syncthreads();
    const XcdBarrier xb = xcd_barrier_post((unsigned*)(P.ws + O_BAR), st);
#define GSYNC() xcd_barrier(xb)
#define DOPH(k) do { if (PHEN(k) && ph_lo <= (k) && (k) < ph_hi) { if (REP(k)) { run_phase<k, true>(P, smem); GSYNC(); } run_phase<k>(P, smem); } \
                     if (ph_lo <= (k) && (k) + 1 < ph_hi) GSYNC(); } while (0)
#ifdef EXTRA_SYNC
    for (int i = 0; i < EXTRA_SYNC; ++i) GSYNC();
#endif
    DOPH(0); DOPH(1); DOPH(2); DOPH(3); DOPH(4); DOPH(5); DOPH(6); DOPH(7); DOPH(8); DOPH(9);
}

#ifndef MK_MULTI
#define MK_MULTI 0
#endif

extern "C" void kernel_launch(void* const* d_in, const int* in_sizes, int n_in, void* d_out, int out_size, void* d_ws, size_t ws_size, hipStream_t stream) {
    (void)in_sizes; (void)n_in; (void)out_size;
    static int grid_blocks = 0;
    if (!grid_blocks) {
        int dev = 0, cus = 0, per_cu = 0;
        hipGetDevice(&dev);
        hipDeviceGetAttribute(&cus, hipDeviceAttributeMultiprocessorCount, dev);
        hipFuncSetAttribute((const void*)hymba_megakernel, hipFuncAttributeMaxDynamicSharedMemorySize, LDS_BYTES);
        hipOccupancyMaxActiveBlocksPerMultiprocessor(&per_cu, hymba_megakernel, 512, LDS_BYTES);
        if (per_cu < 1) per_cu = 1;
        if (per_cu > 1) per_cu = 1;
        grid_blocks = cus * per_cu;
    }
    if (ws_size < WS_TOTAL3) { fprintf(stderr, "workspace too small: %zu < %zu\n", ws_size, (size_t)WS_TOTAL3); return; }
    Params p{};
    const float* const* in = (const float* const*)d_in;
    p.xp = in[0]; p.xs = in[1]; p.ck = in[2]; p.cv = in[3]; p.sC = in[4]; p.sn = in[5]; p.sm = in[6];
    p.g1 = in[7]; p.wg1 = in[8]; p.wu1 = in[9]; p.wd1 = in[10]; p.gmix = in[11]; p.win = in[12]; p.bi = in[13]; p.bfg = in[14];
    p.gout = in[15]; p.gq = in[16]; p.gk = in[17]; p.sinks = in[18]; p.wout = in[19]; p.g2 = in[20]; p.wg2 = in[21]; p.wu2 = in[22]; p.wd2 = in[23];
    p.out = (float*)d_out; p.ws = (unsigned char*)d_ws;
#if MK_MULTI
    for (int ph = 0; ph < NPHASE; ++ph) hipLaunchKernelGGL(hymba_megakernel, dim3(grid_blocks), dim3(512), LDS_BYTES, stream, p, ph, ph + 1);
#else
    hipMemsetAsync((unsigned char*)d_ws + O_BAR, 0, XCD_BAR_WORDS * 4, stream);
    int lo = 0, hi = NPHASE;
    void* args[] = {&p, &lo, &hi};
    hipError_t e = hipLaunchCooperativeKernel((const void*)hymba_megakernel, dim3(grid_blocks), dim3(512), args, LDS_BYTES, stream);
    if (e != hipSuccess) fprintf(stderr, "cooperative launch failed: %s (grid %d)\n", hipGetErrorString(e), grid_blocks);
#endif
}
```
